# Optimizing an MI355X kernel written in HIP

```python
import math
import jax, jax.numpy as jnp
from jax import lax
import numpy as np

D_MODEL = 2048
BATCH = 4
SEQ = 2048
DEPTH = 4
DEC_BATCH = 8
DEC_SEQ = 2048
PAST_LEN = 128

N_MIXERS = 2
N_POOL_LAYERS = (DEPTH + 1) // 2
N_GMLP_LAYERS = DEPTH // 2
POOL_WINDOWS = (2, 4, 8, 16)
N_POOL_GROUPS = len(POOL_WINDOWS)
POOL_GROUP_DIM = D_MODEL // N_POOL_GROUPS
CHUNK = 128
D_GATE = D_MODEL
N_SG_HEADS = 8
SG_HEAD_DIM = D_GATE // N_SG_HEADS
N_MEM = 256
N_XHEADS = 4
XHEAD_DIM = D_MODEL // N_XHEADS
D_FF = int(math.ceil((8 * D_MODEL / 3) / 256) * 256)
N_NORMS = 6
EPS = 1e-6

kernel_name = "hybrid_pool_gmlp_encoder"


def rmsnorm(x, g):
    xf = x.astype(jnp.float32)
    r = xf * lax.rsqrt(jnp.mean(xf * xf, axis=-1, keepdims=True) + EPS)
    return (r * g.astype(jnp.float32)).astype(x.dtype)


def layernorm(x, g, b):
    xf = x.astype(jnp.float32)
    mu = jnp.mean(xf, axis=-1, keepdims=True)
    xc = xf - mu
    var = jnp.mean(xc * xc, axis=-1, keepdims=True)
    y = xc * lax.rsqrt(var + EPS) * g.astype(jnp.float32) + b.astype(jnp.float32)
    return y.astype(x.dtype)


def pool_mixer(x, w_group, scale):
    B, S, D = x.shape
    xf = x.astype(jnp.float32)
    c = jnp.concatenate([jnp.zeros((B, 1, D), jnp.float32), jnp.cumsum(xf, axis=1)], axis=1)
    c = c.reshape(B, S + 1, N_POOL_GROUPS, POOL_GROUP_DIM)
    t = jnp.arange(S, dtype=jnp.int32)[:, None]
    half = jnp.array(POOL_WINDOWS, dtype=jnp.int32)[None, :] // 2
    lo = jnp.clip(t - half, 0, S)
    hi = jnp.clip(t + half, 0, S)
    gidx = jnp.arange(N_POOL_GROUPS, dtype=jnp.int32)[None, :]
    win_sum = c[:, hi, gidx, :] - c[:, lo, gidx, :]
    count = (hi - lo).astype(jnp.float32)[None, :, :, None]
    diff = win_sum / count - xf.reshape(B, S, N_POOL_GROUPS, POOL_GROUP_DIM)
    y = jnp.einsum('bsgc,gcd->bsgd', diff.astype(x.dtype), w_group)
    return y.reshape(B, S, D) * scale


def gmlp_mixer(x, w_in, ln_g, ln_b, w_s, b_s, w_out):
    B, S, D = x.shape
    h = jax.nn.gelu(x @ w_in)
    u, v = h[..., :D_GATE], h[..., D_GATE:]
    v = layernorm(v, ln_g, ln_b)
    v = v.reshape(B, S // CHUNK, CHUNK, N_SG_HEADS, SG_HEAD_DIM)
    mixed = jnp.einsum('hpq,bnqhc->bnphc', w_s, v) + b_s.T[None, None, :, :, None]
    gated = u * mixed.reshape(B, S, D_GATE)
    return gated @ w_out


def cross_attention(x, mem, wq, wk, wv, wo):
    B, S, D = x.shape
    M = mem.shape[1]
    q = (x @ wq).reshape(B, S, N_XHEADS, XHEAD_DIM)
    k = (mem @ wk).reshape(B, M, N_XHEADS, XHEAD_DIM)
    v = (mem @ wv).reshape(B, M, N_XHEADS, XHEAD_DIM)
    s = jnp.einsum('bshd,bmhd->bhsm', q, k).astype(jnp.float32) * (XHEAD_DIM ** -0.5)
    p = jax.nn.softmax(s, axis=-1).astype(x.dtype)
    o = jnp.einsum('bhsm,bmhd->bshd', p, v).reshape(B, S, D)
    return o @ wo


def swiglu(x, w_gate, w_up, w_down):
    return (jax.nn.silu(x @ w_gate) * (x @ w_up)) @ w_down


def trunk(x, mem, norm_gains, mem_norm, pool_w, pool_scale, gmlp_w_in, gmlp_ln_g, gmlp_ln_b,
          gmlp_w_s, gmlp_b_s, gmlp_w_out, attn_wq, attn_wk, attn_wv, attn_wo,
          ffn_w_gate, ffn_w_up, ffn_w_down):
    for i in range(DEPTH):
        g = norm_gains[i]
        j = i // N_MIXERS
        h = rmsnorm(x, g[0])
        if i % N_MIXERS == 0:
            h = pool_mixer(h, pool_w[j], pool_scale[j])
        else:
            h = gmlp_mixer(h, gmlp_w_in[j], gmlp_ln_g[j], gmlp_ln_b[j], gmlp_w_s[j],
                           gmlp_b_s[j], gmlp_w_out[j])
        x = x + rmsnorm(h, g[1])
        memn = rmsnorm(mem, mem_norm[i])
        h = cross_attention(rmsnorm(x, g[2]), memn, attn_wq[i], attn_wk[i], attn_wv[i], attn_wo[i])
        x = x + rmsnorm(h, g[3])
        h = swiglu(rmsnorm(x, g[4]), ffn_w_gate[i], ffn_w_up[i], ffn_w_down[i])
        x = x + rmsnorm(h, g[5])
    return x


def setup_inputs(seed: int = 0) -> dict:
    key = jax.random.key(seed)
    ks = jax.random.split(key, 24)
    f32 = jnp.float32

    def nrm(k, shape, scale):
        return jax.random.normal(k, shape, f32) * scale

    return {
        "x_prompt": nrm(ks[0], (BATCH, SEQ, D_MODEL), 1.0),
        "x_sample": nrm(ks[1], (DEC_BATCH, DEC_SEQ, D_MODEL), 1.0),
        "mem_prompt": nrm(ks[2], (BATCH, N_MEM, D_MODEL), 1.0),
        "mem_sample": nrm(ks[3], (DEC_BATCH, N_MEM, D_MODEL), 1.0),
        "norm_gains": 1.0 + nrm(ks[4], (DEPTH, N_NORMS, D_MODEL), 0.05),
        "mem_norm": 1.0 + nrm(ks[5], (DEPTH, D_MODEL), 0.05),
        "pool_w": nrm(ks[6], (N_POOL_LAYERS, N_POOL_GROUPS, POOL_GROUP_DIM, POOL_GROUP_DIM), POOL_GROUP_DIM ** -0.5),
        "pool_scale": 1.0 + nrm(ks[7], (N_POOL_LAYERS, D_MODEL), 0.1),
        "gmlp_w_in": nrm(ks[8], (N_GMLP_LAYERS, D_MODEL, 2 * D_GATE), D_MODEL ** -0.5),
        "gmlp_ln_g": 1.0 + nrm(ks[9], (N_GMLP_LAYERS, D_GATE), 0.05),
        "gmlp_ln_b": nrm(ks[10], (N_GMLP_LAYERS, D_GATE), 0.02),
        "gmlp_w_s": nrm(ks[11], (N_GMLP_LAYERS, N_SG_HEADS, CHUNK, CHUNK), 0.5 * CHUNK ** -0.5),
        "gmlp_b_s": 1.0 + nrm(ks[12], (N_GMLP_LAYERS, N_SG_HEADS, CHUNK), 0.1),
        "gmlp_w_out": nrm(ks[13], (N_GMLP_LAYERS, D_GATE, D_MODEL), D_GATE ** -0.5),
        "attn_wq": nrm(ks[14], (DEPTH, D_MODEL, D_MODEL), D_MODEL ** -0.5),
        "attn_wk": nrm(ks[15], (DEPTH, D_MODEL, D_MODEL), D_MODEL ** -0.5),
        "attn_wv": nrm(ks[16], (DEPTH, D_MODEL, D_MODEL), D_MODEL ** -0.5),
        "attn_wo": nrm(ks[17], (DEPTH, D_MODEL, D_MODEL), D_MODEL ** -0.5),
        "ffn_w_gate": nrm(ks[18], (DEPTH, D_MODEL, D_FF), D_MODEL ** -0.5),
        "ffn_w_up": nrm(ks[19], (DEPTH, D_MODEL, D_FF), D_MODEL ** -0.5),
        "ffn_w_down": nrm(ks[20], (DEPTH, D_FF, D_MODEL), D_FF ** -0.5),
    }


def reference(x_prompt, x_sample, mem_prompt, mem_sample, norm_gains, mem_norm, pool_w, pool_scale,
              gmlp_w_in, gmlp_ln_g, gmlp_ln_b, gmlp_w_s, gmlp_b_s, gmlp_w_out,
              attn_wq, attn_wk, attn_wv, attn_wo, ffn_w_gate, ffn_w_up, ffn_w_down):
    y_prompt = trunk(x_prompt, mem_prompt, norm_gains, mem_norm, pool_w, pool_scale, gmlp_w_in,
                     gmlp_ln_g, gmlp_ln_b, gmlp_w_s, gmlp_b_s, gmlp_w_out, attn_wq, attn_wk,
                     attn_wv, attn_wo, ffn_w_gate, ffn_w_up, ffn_w_down)
    y_sample = trunk(x_sample, mem_sample, norm_gains, mem_norm, pool_w, pool_scale, gmlp_w_in,
                     gmlp_ln_g, gmlp_ln_b, gmlp_w_s, gmlp_b_s, gmlp_w_out, attn_wq, attn_wk,
                     attn_wv, attn_wo, ffn_w_gate, ffn_w_up, ffn_w_down)
    return (y_prompt, y_sample)
```

```cpp
#include <hip/hip_runtime.h>
#include <cstdio>
#include <cstdint>

namespace nv {
constexpr int D = 2048, SEQ = 2048, NB = 12, M = NB * SEQ, DEPTH = 4, NMEM = 256, MM = NB * NMEM, DFF = 5632, NH = 4, HD = 512;
constexpr float EPS = 1e-6f;

__device__ __forceinline__ float block_sum(float v, float* red) {
#pragma unroll
    for (int o = 32; o >= 1; o >>= 1) v += __shfl_xor(v, o);
    const int w = threadIdx.x >> 6, l = threadIdx.x & 63;
    __syncthreads();
    if (l == 0) red[w] = v;
    __syncthreads();
    float s = 0.f;
    for (int i = 0; i < (int)(blockDim.x >> 6); ++i) s += red[i];
    return s;
}
__global__ void k_rmsnorm(const float* x0, const float* x1, int split, const float* g, float* out, int Dn) {
    __shared__ float red[8];
    const int row = blockIdx.x;
    const float* xr = row < split ? x0 + (size_t)row * Dn : x1 + (size_t)(row - split) * Dn;
    float s = 0.f;
    for (int c = threadIdx.x; c < Dn; c += blockDim.x) { const float v = xr[c]; s += v * v; }
    s = block_sum(s, red);
    const float rinv = rsqrtf(s / (float)Dn + EPS);
    for (int c = threadIdx.x; c < Dn; c += blockDim.x) out[(size_t)row * Dn + c] = xr[c] * rinv * (g ? g[c] : 1.f);
}
__global__ void k_resid_postnorm(float* x, const float* h, const float* g, int Dn) {
    __shared__ float red[8];
    const int row = blockIdx.x;
    const float* hr = h + (size_t)row * Dn;
    float s = 0.f;
    for (int c = threadIdx.x; c < Dn; c += blockDim.x) { const float v = hr[c]; s += v * v; }
    s = block_sum(s, red);
    const float rinv = rsqrtf(s / (float)Dn + EPS);
    for (int c = threadIdx.x; c < Dn; c += blockDim.x) x[(size_t)row * Dn + c] += hr[c] * rinv * g[c];
}
__global__ void k_layernorm(const float* in, int ldi, const float* g, const float* b, float* out, int Dn) {
    __shared__ float red[8];
    const int row = blockIdx.x;
    const float* ir = in + (size_t)row * ldi;
    float s = 0.f;
    for (int c = threadIdx.x; c < Dn; c += blockDim.x) s += ir[c];
    s = block_sum(s, red);
    const float mu = s / (float)Dn;
    float q = 0.f;
    for (int c = threadIdx.x; c < Dn; c += blockDim.x) { const float d = ir[c] - mu; q += d * d; }
    q = block_sum(q, red);
    const float rstd = rsqrtf(q / (float)Dn + EPS);
    for (int c = threadIdx.x; c < Dn; c += blockDim.x) out[(size_t)row * Dn + c] = (ir[c] - mu) * rstd * g[c] + b[c];
}
__global__ void k_pool_diff(const float* h, float* out) {
    const size_t i = (size_t)blockIdx.x * blockDim.x + threadIdx.x;
    if (i >= (size_t)M * D) return;
    const int c = (int)(i % D); const int row = (int)(i / D); const int b = row / SEQ, t = row % SEQ;
    const int half = 1 << (c / 512);
    const int lo = max(t - half, 0), hi = min(t + half, SEQ);
    float s = 0.f;
    for (int tt = lo; tt < hi; ++tt) s += h[((size_t)b * SEQ + tt) * D + c];
    out[i] = s / (float)(hi - lo) - h[i];
}
__device__ __forceinline__ float gelu_tanh(float x) { const float u = 0.7978845608028654f * (x + 0.044715f * x * x * x); return 0.5f * x * (1.f + tanhf(u)); }
struct GemmP { const float* A; const float* B; float* C; int lda, ldb, ldc, K, transB, act, zd; long sA1, sA2, sB1, sB2, sC1, sC2, sS1; float alpha; const float* colscale; };
__global__ void __launch_bounds__(256) k_sgemm(GemmP p) {
    __shared__ float As[8][128 + 4];
    __shared__ float Bs[8][128 + 4];
    const int z = blockIdx.z, z1 = z / p.zd, z2 = z % p.zd;
    const float* A = p.A + z1 * p.sA1 + z2 * p.sA2 + (size_t)blockIdx.y * 128 * p.lda;
    const float* B = p.B + z1 * p.sB1 + z2 * p.sB2;
    float* C = p.C + z1 * p.sC1 + z2 * p.sC2;
    const float* cs = p.colscale ? p.colscale + z1 * p.sS1 : nullptr;
    const int n0 = blockIdx.x * 128, t = threadIdx.x, ty = t >> 4, tx = t & 15;
    float acc[8][8];
#pragma unroll
    for (int i = 0; i < 8; ++i)
#pragma unroll
        for (int j = 0; j < 8; ++j) acc[i][j] = 0.f;
    for (int k0 = 0; k0 < p.K; k0 += 8) {
        { const int r = t >> 1, kk = (t & 1) * 4; const float4 v = *(const float4*)(A + (size_t)r * p.lda + k0 + kk);
          As[kk + 0][r] = v.x; As[kk + 1][r] = v.y; As[kk + 2][r] = v.z; As[kk + 3][r] = v.w; }
        if (p.transB) { const int r = t >> 1, kk = (t & 1) * 4; const float4 v = *(const float4*)(B + (size_t)(n0 + r) * p.ldb + k0 + kk);
          Bs[kk + 0][r] = v.x; Bs[kk + 1][r] = v.y; Bs[kk + 2][r] = v.z; Bs[kk + 3][r] = v.w; }
        else { const int kk = t >> 5, nn = (t & 31) * 4; const float4 v = *(const float4*)(B + (size_t)(k0 + kk) * p.ldb + n0 + nn);
          *(float4*)&Bs[kk][nn] = v; }
        __syncthreads();
#pragma unroll
        for (int kk = 0; kk < 8; ++kk) {
            float a[8], b[8];
            *(float4*)&a[0] = *(const float4*)&As[kk][ty * 8]; *(float4*)&a[4] = *(const float4*)&As[kk][ty * 8 + 4];
            *(float4*)&b[0] = *(const float4*)&Bs[kk][tx * 8]; *(float4*)&b[4] = *(const float4*)&Bs[kk][tx * 8 + 4];
#pragma unroll
            for (int i = 0; i < 8; ++i)
#pragma unroll
                for (int j = 0; j < 8; ++j) acc[i][j] += a[i] * b[j];
        }
        __syncthreads();
    }
#pragma unroll
    for (int i = 0; i < 8; ++i) {
        const int r = blockIdx.y * 128 + ty * 8 + i;
        float o[8];
#pragma unroll
        for (int j = 0; j < 8; ++j) { float v = acc[i][j] * p.alpha; if (p.act == 1) v = gelu_tanh(v); if (cs) v *= cs[n0 + tx * 8 + j]; o[j] = v; }
        float* cp = C + (size_t)r * p.ldc + n0 + tx * 8;
        *(float4*)cp = *(float4*)&o[0]; *(float4*)(cp + 4) = *(float4*)&o[4];
    }
}
__global__ void k_gate(const float* hh, float* mixed, const float* bs) {
    const size_t i = (size_t)blockIdx.x * blockDim.x + threadIdx.x;
    if (i >= (size_t)M * D) return;
    const int c = (int)(i % D); const int r = (int)(i / D);
    mixed[i] = hh[(size_t)r * 4096 + c] * (mixed[i] + bs[(c / 256) * 128 + (r % 128)]);
}
__global__ void k_softmax256(float* s) {
    const size_t row = (size_t)blockIdx.x * (blockDim.x >> 6) + (threadIdx.x >> 6); const int l = threadIdx.x & 63;
    float* r = s + row * 256; float v[4]; float m = -1e30f;
#pragma unroll
    for (int j = 0; j < 4; ++j) { v[j] = r[l + 64 * j]; m = fmaxf(m, v[j]); }
#pragma unroll
    for (int o = 32; o >= 1; o >>= 1) m = fmaxf(m, __shfl_xor(m, o));
    float sum = 0.f;
#pragma unroll
    for (int j = 0; j < 4; ++j) { v[j] = expf(v[j] - m); sum += v[j]; }
#pragma unroll
    for (int o = 32; o >= 1; o >>= 1) sum += __shfl_xor(sum, o);
    const float inv = 1.f / sum;
#pragma unroll
    for (int j = 0; j < 4; ++j) r[l + 64 * j] = v[j] * inv;
}
__global__ void k_swiglu(float* g, const float* u, size_t n) {
    const size_t i = (size_t)blockIdx.x * blockDim.x + threadIdx.x;
    if (i >= n) return;
    const float a = g[i]; g[i] = a / (1.f + expf(-a)) * u[i];
}

static void sgemm(hipStream_t st, const float* A, int lda, const float* B, int ldb, float* C, int ldc, int Mr, int N, int K, int transB = 0, int act = 0, float alpha = 1.f,
                  const float* colscale = nullptr, int nz = 1, int zd = 1, long sA1 = 0, long sA2 = 0, long sB1 = 0, long sB2 = 0, long sC1 = 0, long sC2 = 0, long sS1 = 0) {
    GemmP p{}; p.A = A; p.B = B; p.C = C; p.lda = lda; p.ldb = ldb; p.ldc = ldc; p.K = K; p.transB = transB; p.act = act; p.zd = zd;
    p.sA1 = sA1; p.sA2 = sA2; p.sB1 = sB1; p.sB2 = sB2; p.sC1 = sC1; p.sC2 = sC2; p.sS1 = sS1; p.alpha = alpha; p.colscale = colscale;
    hipLaunchKernelGGL(k_sgemm, dim3(N / 128, Mr / 128, nz), dim3(256), 0, st, p);
}

static void forward(void* const* d_in, float* X, float* ws, hipStream_t st) {
    const float* x_prompt = (const float*)d_in[0]; const float* x_sample = (const float*)d_in[1];
    const float* mem_prompt = (const float*)d_in[2]; const float* mem_sample = (const float*)d_in[3];
    const float* norm_gains = (const float*)d_in[4]; const float* mem_norm = (const float*)d_in[5];
    const float* pool_w = (const float*)d_in[6]; const float* pool_scale = (const float*)d_in[7];
    const float* gmlp_w_in = (const float*)d_in[8]; const float* gmlp_ln_g = (const float*)d_in[9]; const float* gmlp_ln_b = (const float*)d_in[10];
    const float* gmlp_w_s = (const float*)d_in[11]; const float* gmlp_b_s = (const float*)d_in[12]; const float* gmlp_w_out = (const float*)d_in[13];
    const float* attn_wq = (const float*)d_in[14]; const float* attn_wk = (const float*)d_in[15]; const float* attn_wv = (const float*)d_in[16]; const float* attn_wo = (const float*)d_in[17];
    const float* ffn_w_gate = (const float*)d_in[18]; const float* ffn_w_up = (const float*)d_in[19]; const float* ffn_w_down = (const float*)d_in[20];
    const size_t MD = (size_t)M * D;
    float* hn = ws;
    float* h2 = hn + MD;
    float* big = h2 + MD;
    float* memn = big + (size_t)M * 4096;
    float* kb = memn + (size_t)MM * D;
    float* vb = kb + (size_t)MM * D;
    hipMemcpyAsync(X, x_prompt, (size_t)4 * SEQ * D * 4, hipMemcpyDeviceToDevice, st);
    hipMemcpyAsync(X + (size_t)4 * SEQ * D, x_sample, (size_t)8 * SEQ * D * 4, hipMemcpyDeviceToDevice, st);
    const int EB = 256; const unsigned egrid = (unsigned)((MD + EB - 1) / EB);
    for (int i = 0; i < DEPTH; ++i) {
        const float* g = norm_gains + (size_t)i * 6 * D; const int j = i / 2;
        hipLaunchKernelGGL(k_rmsnorm, dim3(M), dim3(256), 0, st, X, X, M, g + 0 * D, hn, D);
        if (i % 2 == 0) {
            hipLaunchKernelGGL(k_pool_diff, dim3(egrid), dim3(EB), 0, st, hn, h2);
            sgemm(st, h2, D, pool_w + (size_t)j * 4 * 512 * 512, 512, hn, D, M, 512, 512, 0, 0, 1.f, pool_scale + (size_t)j * D, 4, 1, 512, 0, 512 * 512, 0, 512, 0, 512);
        } else {
            float* hh = big;
            sgemm(st, hn, D, gmlp_w_in + (size_t)j * D * 4096, 4096, hh, 4096, M, 4096, D, 0, 1);
            hipLaunchKernelGGL(k_layernorm, dim3(M), dim3(256), 0, st, hh + 2048, 4096, gmlp_ln_g + (size_t)j * D, gmlp_ln_b + (size_t)j * D, hn, D);
            sgemm(st, gmlp_w_s + (size_t)j * 8 * 128 * 128, 128, hn, D, h2, D, 128, 256, 128, 0, 0, 1.f, nullptr, 192 * 8, 8, 0, 128 * 128, (long)128 * D, 256, (long)128 * D, 256);
            hipLaunchKernelGGL(k_gate, dim3(egrid), dim3(EB), 0, st, hh, h2, gmlp_b_s + (size_t)j * 8 * 128);
            sgemm(st, h2, D, gmlp_w_out + (size_t)j * D * D, D, hn, D, M, D, D);
        }
        hipLaunchKernelGGL(k_resid_postnorm, dim3(M), dim3(256), 0, st, X, hn, g + 1 * D, D);
        hipLaunchKernelGGL(k_rmsnorm, dim3(MM), dim3(256), 0, st, mem_prompt, mem_sample, 4 * NMEM, mem_norm + (size_t)i * D, memn, D);
        sgemm(st, memn, D, attn_wk + (size_t)i * D * D, D, kb, D, MM, D, D);
        sgemm(st, memn, D, attn_wv + (size_t)i * D * D, D, vb, D, MM, D, D);
        hipLaunchKernelGGL(k_rmsnorm, dim3(M), dim3(256), 0, st, X, X, M, g + 2 * D, hn, D);
        sgemm(st, hn, D, attn_wq + (size_t)i * D * D, D, h2, D, M, D, D);
        float* sc = big;
        sgemm(st, h2, D, kb, D, sc, 256, SEQ, 256, HD, 1, 0, 0.04419417382415922f, nullptr, NB * NH, NH, (long)SEQ * D, HD, (long)NMEM * D, HD, (long)NH * SEQ * 256, (long)SEQ * 256);
        hipLaunchKernelGGL(k_softmax256, dim3(NB * NH * SEQ / 4), dim3(256), 0, st, sc);
        sgemm(st, sc, 256, vb, D, hn, D, SEQ, HD, 256, 0, 0, 1.f, nullptr, NB * NH, NH, (long)NH * SEQ * 256, (long)SEQ * 256, (long)NMEM * D, HD, (long)SEQ * D, HD);
        sgemm(st, hn, D, attn_wo + (size_t)i * D * D, D, h2, D, M, D, D);
        hipLaunchKernelGGL(k_resid_postnorm, dim3(M), dim3(256), 0, st, X, h2, g + 3 * D, D);
        hipLaunchKernelGGL(k_rmsnorm, dim3(M), dim3(256), 0, st, X, X, M, g + 4 * D, hn, D);
        for (int ch = 0; ch < 3; ++ch) {
            const int R = 8192; float* gt = big; float* up = big + (size_t)R * DFF; const float* a = hn + (size_t)ch * R * D;
            sgemm(st, a, D, ffn_w_gate + (size_t)i * D * DFF, DFF, gt, DFF, R, DFF, D);
            sgemm(st, a, D, ffn_w_up + (size_t)i * D * DFF, DFF, up, DFF, R, DFF, D);
            const size_t n = (size_t)R * DFF;
            hipLaunchKernelGGL(k_swiglu, dim3((unsigned)((n + 255) / 256)), dim3(256), 0, st, gt, up, n);
            sgemm(st, gt, DFF, ffn_w_down + (size_t)i * DFF * D, D, h2 + (size_t)ch * R * D, D, R, D, DFF);
        }
        hipLaunchKernelGGL(k_resid_postnorm, dim3(M), dim3(256), 0, st, X, h2, g + 5 * D, D);
    }
}
}

extern "C" void kernel_launch(void* const* d_in, const int* in_sizes, int n_in, void* d_out, int out_size, void* d_ws, size_t ws_size, hipStream_t stream) {
    (void)in_sizes; (void)n_in; (void)out_size; (void)ws_size;
    nv::forward(d_in, (float*)d_out, (float*)d_ws, stream);
}
```

```cpp
#include <hip/hip_runtime.h>
#include <cstdio>
#include <cstdint>

namespace mk {
#define LAS __attribute__((address_space(3)))
#define GAS __attribute__((address_space(1)))
typedef unsigned short bf16_t;
typedef short bf16x8 __attribute__((ext_vector_type(8)));
typedef float f32x4 __attribute__((ext_vector_type(4)));
typedef float f32x2 __attribute__((ext_vector_type(2)));
typedef unsigned u32x4 __attribute__((ext_vector_type(4)));
typedef unsigned u32x2 __attribute__((ext_vector_type(2)));

constexpr int D = 2048, SEQ = 2048, NB = 12, M = NB * SEQ, DEPTH = 4, NMEM = 256, MM = NB * NMEM, DFF = 5632, NH = 4, HD = 512, DG = 2048;
constexpr int NPROMPT_ROWS = 4 * SEQ, NPROMPT_MEM = 4 * NMEM;
constexpr float EPS = 1e-6f;
constexpr int NWAVES = 8, NTHREADS = 512, GRID = 256;
#ifndef PHASES
#define PHASES 0xFFFFF
#endif
#define PH(b) ((PHASES >> (b)) & 1)

constexpr size_t MiB = 1u << 20;
constexpr size_t WS_CTL = 0, CTL_BYTES = 1 * MiB;
constexpr size_t WS_WPOOL = 1 * MiB;
constexpr size_t WS_WS = WS_WPOOL + 4 * MiB;
constexpr size_t WS_WIN = WS_WS + 1 * MiB;
constexpr size_t WS_WOUT = WS_WIN + 32 * MiB;
constexpr size_t WS_WQ = WS_WOUT + 16 * MiB;
constexpr size_t WS_WK = WS_WQ + 32 * MiB;
constexpr size_t WS_WV = WS_WK + 32 * MiB;
constexpr size_t WS_WO = WS_WV + 32 * MiB;
constexpr size_t WS_WGU = WS_WO + 32 * MiB;
constexpr size_t WS_WDN = WS_WGU + 176 * MiB;
constexpr size_t WS_MEMBN = WS_WDN + 88 * MiB;
constexpr size_t WS_KMAT = WS_MEMBN + 12 * MiB;
constexpr size_t WS_VT = WS_KMAT + 48 * MiB;
constexpr size_t WS_XB = WS_VT + 48 * MiB;
constexpr size_t WS_HB = WS_XB + 96 * MiB;
constexpr size_t WS_BIG = WS_HB + 96 * MiB;
constexpr size_t WS_SSP = WS_BIG + 264 * MiB;
constexpr size_t WS_VST = WS_SSP + 3 * MiB;
constexpr size_t WS_RSP = WS_VST + 6 * MiB;
constexpr size_t WS_END = WS_RSP + 2 * MiB;
constexpr size_t BIG_U = 0, BIG_V = 96 * MiB, BIG_DA = 0, BIG_Q = 0, BIG_O = 96 * MiB, BIG_PT = 192 * MiB, BIG_HF = 0;
constexpr int CW_BAR = 4096;

constexpr int RING_BYTES = 131072, RED_OFF = RING_BYTES, RED_BYTES = 4096, MISC_OFF = RED_OFF + RED_BYTES, LDS_BYTES = 147456;

#define LDS_WAIT() asm volatile("s_waitcnt lgkmcnt(0)" ::: "memory")
#define VM_WAIT() asm volatile("s_waitcnt vmcnt(0)" ::: "memory")

#define XB_TMO      128
#define XB_XCNT(j)  (256  + 64 * (j))
#define XB_XSUB(j)  (1280 + 64 * (j))
#define XB_XGEN(j)  (2304 + 64 * (j))
#define XB_TOP      3328
#define XB_TOPGEN   3392
#define XCD_BAR_WORDS 3456
#define XB_SPIN_CAP (1u << 18)
__device__ __forceinline__ unsigned xb_ld(unsigned* p)              { return __hip_atomic_load(p, __ATOMIC_RELAXED, __HIP_MEMORY_SCOPE_AGENT); }
__device__ __forceinline__ unsigned xb_add(unsigned* p, unsigned v) { return __hip_atomic_fetch_add(p, v, __ATOMIC_RELAXED, __HIP_MEMORY_SCOPE_AGENT); }
__device__ __forceinline__ unsigned xb_xcc_id() { return (unsigned)__builtin_amdgcn_s_getreg((3 << 11) | 20) & 0xFu; }
#define XB_SPIN(cond, bar) do { unsigned _sp = 0; while (cond) { __builtin_amdgcn_s_sleep(1); \
    if ((++_sp & 255u) == 0u) { if (xb_ld(&(bar)[XB_TMO])) break; if (_sp > XB_SPIN_CAP) { atomicAdd(&(bar)[XB_TMO], 1u); break; } } } } while (0)
struct XcdBarrier { unsigned* bar; unsigned x; volatile LAS unsigned* st; };
__device__ __forceinline__ XcdBarrier xcd_barrier_post(unsigned* bar, volatile LAS unsigned* st) {
    XcdBarrier b; b.bar = bar; b.x = xb_xcc_id(); b.st = st;
    if (threadIdx.x == 0) (void)xb_add(&bar[XB_XCNT(b.x)], 1u);
    return b;
}
__device__ __forceinline__ void xcd_barrier_complete(unsigned* bar, unsigned x, unsigned& nloc, unsigned& nx) {
    const unsigned G = gridDim.x * gridDim.y * gridDim.z;
    unsigned sum, cnt, mine, sp = 0u;
    for (;;) {
        sum = 0u; cnt = 0u; mine = 0u;
#pragma unroll
        for (unsigned j = 0; j < 16; ++j) { const unsigned c = xb_ld(&bar[XB_XCNT(j)]); sum += c; cnt += (c > 0u) ? 1u : 0u; mine = (j == x) ? c : mine; }
        if (sum == G) break;
        __builtin_amdgcn_s_sleep(1);
        if ((++sp & 255u) == 0u) { if (xb_ld(&bar[XB_TMO])) break; if (sp > XB_SPIN_CAP) { atomicAdd(&bar[XB_TMO], 1u); break; } }
    }
    nloc = mine > 0u ? mine : 1u; nx = cnt > 0u ? cnt : 1u;
}
__device__ __forceinline__ void xcd_barrier(const XcdBarrier& b) {
    asm volatile("s_waitcnt vmcnt(0)" ::: "memory");
    __syncthreads();
    if (threadIdx.x == 0) {
        unsigned* bar = b.bar;
        __builtin_amdgcn_s_waitcnt(0);
        unsigned nloc = b.st[0], nx = b.st[1];
        if (nloc == 0u) { xcd_barrier_complete(bar, b.x, nloc, nx); b.st[0] = nloc; b.st[1] = nx; }
        const unsigned old = xb_add(&bar[XB_XSUB(b.x)], 1u);
        const unsigned gen = old / nloc;
        if (old + 1u == (gen + 1u) * nloc) {
            __builtin_amdgcn_fence(__ATOMIC_RELEASE, "agent");
            asm volatile("s_waitcnt vmcnt(0)" ::: "memory");
            const unsigned og = xb_add(&bar[XB_TOP], 1u);
            const unsigned tg = og / nx;
            if (og + 1u == (tg + 1u) * nx) xb_add(&bar[XB_TOPGEN], 1u);
            else XB_SPIN(xb_ld(&bar[XB_TOPGEN]) == tg, bar);
            __builtin_amdgcn_fence(__ATOMIC_ACQUIRE, "agent");
            xb_add(&bar[XB_XGEN(b.x)], 1u);
            asm volatile("s_waitcnt vmcnt(0)" ::: "memory");
        } else {
            XB_SPIN(xb_ld(&bar[XB_XGEN(b.x)]) == gen, bar);
            __builtin_amdgcn_fence(__ATOMIC_ACQUIRE, "agent");
            asm volatile("s_waitcnt vmcnt(0)" ::: "memory");
        }
    }
    __syncthreads();
}

__device__ __forceinline__ unsigned cvt_pk_bf16(float lo, float hi) { unsigned r; asm volatile("v_cvt_pk_bf16_f32 %0, %1, %2" : "=v"(r) : "v"(lo), "v"(hi)); return r; }
__device__ __forceinline__ float bf_lo(unsigned w) { return __uint_as_float(w << 16); }
__device__ __forceinline__ float bf_hi(unsigned w) { return __uint_as_float(w & 0xffff0000u); }
__device__ __forceinline__ float wave_sum(float v) {
#pragma unroll
    for (int o = 1; o < 64; o <<= 1) v += __shfl_xor(v, o);
    return v;
}
__device__ __forceinline__ float fast_exp(float x) { return __builtin_amdgcn_exp2f(x * 1.4426950408889634f); }
__device__ __forceinline__ float gelu_tanh_f(float x) {
    const float u = x * (1.5957691216057308f + 0.07135481282803448f * x * x);
    return x * __builtin_amdgcn_rcpf(1.f + fast_exp(-u));
}
__device__ __forceinline__ float silu_f(float x) { return x * __builtin_amdgcn_rcpf(1.f + fast_exp(-x)); }

constexpr int BM = 256, BK = 64, HALF = 128, HTB = HALF * BK * 2, NXCD = 8, WGM = 8;
__device__ __forceinline__ int lds_byte(int r, int c) { const int st = (r >> 4) * 2 + (c >> 5), rr = r & 15, cc = c & 31, ob = rr * 64 + cc * 2; return st * 1024 + (ob ^ (((ob >> 9) & 1) << 5)); }
__device__ __forceinline__ void stage_rc(int b, int& R, int& C) { const int st = b / 1024, sb = b % 1024, swz = sb ^ (((sb >> 9) & 1) << 5); R = (st >> 1) * 16 + swz / 64; C = (st & 1) * 32 + (swz % 64) / 2; }
__device__ __forceinline__ int perm32(int rho) { const int n = rho >> 4, i = rho & 15; return 8 * (i >> 2) + 4 * n + (i & 3); }

struct GU { const char* A; const char* B; int r0, c0, aux; };
struct Tile { int pm, pn; };
template <int nM, int nN> struct Order {
    static constexpr int nwg = nM * nN, G = GRID;
    __device__ __forceinline__ bool tile(int i, Tile& t) const {
        int c = (int)blockIdx.x; asm volatile("" : "+s"(c));
        const long L = (long)i * G + c; if (L >= nwg) return false;
        int wgid = (int)L; { const int q = nwg / NXCD, r = nwg % NXCD, xcd = wgid % NXCD, off = wgid / NXCD; wgid = (xcd < r ? xcd * (q + 1) : r * (q + 1) + (xcd - r) * q) + off; }
        const int nig = WGM * nN, gid = wgid / nig, fm = gid * WGM, gsz = (nM - fm) < WGM ? (nM - fm) : WGM;
        t.pm = fm + ((wgid % nig) % gsz); t.pn = (wgid % nig) / gsz; return true;
    }
};
template <class Epi, class Map, bool ALIGN_EPI>
__device__ __forceinline__ void gemm_phase(LAS unsigned char* lds, const Map& S, const Epi& E, const int K, const int lda, const int ldb) {
    int tid_ = threadIdx.x; asm volatile("" : "+v"(tid_));
    const int tid = tid_, wid = __builtin_amdgcn_readfirstlane(tid >> 6), lane = tid & 63, wr = wid >> 2, wc = wid & 3, fr = lane & 15, fq = lane >> 4;
    const int nt = K / BK;
    unsigned voffA[2], voffB[2];
#pragma unroll
    for (int i = 0; i < 2; ++i) { int R, C; stage_rc(tid * 16 + i * 8192, R, C); const int Rb = (R & ~31) + perm32(R & 31);
        voffA[i] = (unsigned)(R * lda + C) * 2u; voffB[i] = (unsigned)(Rb * ldb + C) * 2u; }
    const size_t kstep = (size_t)(BK * 2);
    const size_t hstepA = (size_t)HALF * lda * 2, hstepB = (size_t)HALF * ldb * 2;
    const unsigned ldsw = (unsigned)wid * 1024u;
    const int aoff = lds_byte(wr * 64 + fr, fq * 8), boff = lds_byte(wc * 32 + fr, fq * 8);
#define PG8_SA(b, h) (((b) * 2 + (h)) * HTB)
#define PG8_SB(b, h) ((4 + (b) * 2 + (h)) * HTB)
#define PG8_STAGE(bufoff, gbase, voff) do { _Pragma("unroll") for (int _i = 0; _i < 2; ++_i) \
        __builtin_amdgcn_global_load_lds((const unsigned*)((const char*)(gbase) + (voff)[_i]), (LAS unsigned*)(lds + (bufoff) + ldsw + _i * 8192), 16, 0, 0); } while (0)
#define PG8_LDA(dst, b, h) do { _Pragma("unroll") for (int m = 0; m < 4; ++m) _Pragma("unroll") for (int k = 0; k < 2; ++k) dst[m][k] = *(const LAS bf16x8*)(lds + PG8_SA(b, h) + aoff + m * 2048 + k * 1024); } while (0)
#define PG8_LDB(dst, b, h) do { _Pragma("unroll") for (int n = 0; n < 2; ++n) _Pragma("unroll") for (int k = 0; k < 2; ++k) dst[n][k] = *(const LAS bf16x8*)(lds + PG8_SB(b, h) + boff + n * 2048 + k * 1024); } while (0)
#define PG8_MMA(ai, bj, At, Bt) do { __builtin_amdgcn_s_setprio(1); _Pragma("unroll") for (int m = 0; m < 4; ++m) _Pragma("unroll") for (int n = 0; n < 2; ++n) _Pragma("unroll") for (int k = 0; k < 2; ++k) \
        acc[ai][bj][m][n] = __builtin_amdgcn_mfma_f32_16x16x32_bf16(Bt[n][k], At[m][k], acc[ai][bj][m][n], 0, 0, 0); __builtin_amdgcn_s_setprio(0); } while (0)
#define PG8_WAIT_V(n) asm volatile("s_waitcnt vmcnt(" #n ")" ::: "memory")
#define PG8_WAIT_L(n) asm volatile("s_waitcnt lgkmcnt(" #n ")" ::: "memory")
#define PG8_BAR __builtin_amdgcn_s_barrier()
#define PG8_SCHED __builtin_amdgcn_sched_barrier(0)
    GU cur, nxt; int ui = 0;
    if (!S.next(0, cur)) return;
    f32x4 acc[2][2][4][2];
#pragma unroll
    for (int a = 0; a < 2; ++a)
#pragma unroll
        for (int b = 0; b < 2; ++b)
#pragma unroll
            for (int m = 0; m < 4; ++m)
#pragma unroll
                for (int n = 0; n < 2; ++n) acc[a][b][m][n] = (f32x4){0.f, 0.f, 0.f, 0.f};
    bf16x8 At[4][2], B0[2][2], B1[2][2];
    const char* cA = cur.A; const char* cB = cur.B;
    PG8_STAGE(PG8_SB(0, 0), cB, voffB); PG8_STAGE(PG8_SB(0, 1), cB + hstepB, voffB); PG8_STAGE(PG8_SA(0, 0), cA, voffA); PG8_STAGE(PG8_SA(0, 1), cA + hstepA, voffA);
    if (wr == 1) PG8_BAR;
    PG8_WAIT_V(2); PG8_BAR;
    PG8_STAGE(PG8_SB(1, 0), cB + kstep, voffB); PG8_STAGE(PG8_SA(1, 0), cA + kstep, voffA); PG8_STAGE(PG8_SB(1, 1), cB + hstepB + kstep, voffB);
    PG8_WAIT_V(6); PG8_BAR;
    for (;;) {
        const bool has_next = S.next(ui + 1, nxt);
        const char* nA = has_next ? nxt.A : cA; const char* nB = has_next ? nxt.B : cB;
        for (int t = 0; t < nt; t += 2) {
            const bool last = (t == nt - 2);
            const char* a1 = cA + (size_t)(t + 1) * kstep;
            const char* a2 = last ? nA : cA + (size_t)(t + 2) * kstep; const char* b2 = last ? nB : cB + (size_t)(t + 2) * kstep;
            const char* a3 = a2 + kstep; const char* b3 = b2 + kstep;
            PG8_LDB(B0, 0, 0); PG8_LDB(B1, 0, 1); PG8_SCHED; PG8_LDA(At, 0, 0); PG8_STAGE(PG8_SA(1, 1), a1 + hstepA, voffA);
            PG8_WAIT_V(8); PG8_WAIT_L(0); PG8_BAR; PG8_MMA(0, 0, At, B0); PG8_MMA(0, 1, At, B1); PG8_BAR; PG8_SCHED;
            PG8_LDA(At, 0, 1); PG8_STAGE(PG8_SB(0, 0), b2, voffB); PG8_STAGE(PG8_SB(0, 1), b2 + hstepB, voffB); PG8_STAGE(PG8_SA(0, 0), a2, voffA);
            PG8_WAIT_V(8); PG8_WAIT_L(0); PG8_BAR; PG8_MMA(1, 0, At, B0); PG8_MMA(1, 1, At, B1); PG8_BAR; PG8_SCHED;
            PG8_LDB(B0, 1, 0); PG8_LDB(B1, 1, 1); PG8_SCHED; PG8_LDA(At, 1, 0); PG8_STAGE(PG8_SA(0, 1), a2 + hstepA, voffA);
            PG8_WAIT_V(8); PG8_WAIT_L(0); PG8_BAR; PG8_MMA(0, 0, At, B0); PG8_MMA(0, 1, At, B1); PG8_BAR; PG8_SCHED;
            PG8_LDA(At, 1, 1); PG8_STAGE(PG8_SB(1, 0), b3, voffB); PG8_STAGE(PG8_SB(1, 1), b3 + hstepB, voffB); PG8_STAGE(PG8_SA(1, 0), a3, voffA);
            PG8_WAIT_V(8); PG8_WAIT_L(0); PG8_BAR; PG8_MMA(1, 0, At, B0); PG8_MMA(1, 1, At, B1); PG8_BAR; PG8_SCHED;
        }
        if constexpr (ALIGN_EPI) { if (wr == 0) PG8_BAR; }
        E(acc, cur, wr, wc, fr, fq, lds);
        if (!has_next) break;
#pragma unroll
        for (int a = 0; a < 2; ++a)
#pragma unroll
            for (int b = 0; b < 2; ++b)
#pragma unroll
                for (int m = 0; m < 4; ++m)
#pragma unroll
                    for (int n = 0; n < 2; ++n) acc[a][b][m][n] = (f32x4){0.f, 0.f, 0.f, 0.f};
        cur = nxt; cA = nA; cB = nB; ++ui;
        if constexpr (ALIGN_EPI) { if (wr == 1) PG8_BAR; }
    }
    PG8_WAIT_V(0);
    if constexpr (!ALIGN_EPI) { if (wr == 0) PG8_BAR; }
    PG8_BAR;
#undef PG8_SA
#undef PG8_SB
#undef PG8_STAGE
#undef PG8_LDA
#undef PG8_LDB
#undef PG8_MMA
#undef PG8_WAIT_V
#undef PG8_WAIT_L
#undef PG8_BAR
#undef PG8_SCHED
}

template <int nM, int nN, int c0mul> struct MapReg {
    Order<nM, nN> o; const char* A; const char* B; size_t astep, bstep;
    __device__ __forceinline__ bool next(int i, GU& u) const { Tile t; if (!o.tile(i, t)) return false;
        u.A = A + (size_t)t.pm * astep; u.B = B + (size_t)t.pn * bstep; u.r0 = t.pm * BM; u.c0 = t.pn * c0mul; u.aux = t.pn; return true; }
};
struct MapPool {
    Order<M / BM, D / BM> o; const char* A; const char* B;
    __device__ __forceinline__ bool next(int i, GU& u) const { Tile t; if (!o.tile(i, t)) return false;
        u.A = A + ((size_t)t.pm * BM * D + (size_t)(t.pn >> 1) * 512) * 2; u.B = B + (size_t)t.pn * BM * 512 * 2; u.r0 = t.pm * BM; u.c0 = t.pn * BM; u.aux = t.pn; return true; }
};
struct MapS {
    Order<M / BM, NH> o; const char* Q; const char* Kl;
    __device__ __forceinline__ bool next(int i, GU& u) const { Tile t; if (!o.tile(i, t)) return false;
        u.A = Q + ((size_t)t.pm * BM * D + (size_t)t.pn * HD) * 2; u.B = Kl + ((size_t)(t.pm >> 3) * NMEM * (4 * D) + (size_t)t.pn * HD) * 2; u.r0 = t.pm * BM; u.c0 = t.pn * NMEM; u.aux = t.pn; return true; }
};
struct MapPV {
    Order<M / BM, D / BM> o; const char* P; const char* Vl;
    __device__ __forceinline__ bool next(int i, GU& u) const { Tile t; if (!o.tile(i, t)) return false;
        u.A = P + ((size_t)t.pm * BM * 1024 + (size_t)(t.pn >> 1) * NMEM) * 2; u.B = Vl + ((size_t)t.pn * BM * MM + (size_t)(t.pm >> 3) * NMEM) * 2; u.r0 = t.pm * BM; u.c0 = t.pn * BM; u.aux = t.pn >> 1; return true; }
};

template <bool SS> struct EpiPlain {
    bf16_t* O; int ldc; float* ssp;
    __device__ __forceinline__ void operator()(const f32x4 (&acc)[2][2][4][2], const GU& u, int wr, int wc, int fr, int fq, LAS unsigned char*) const {
        const int row0 = u.r0 + wr * 64 + fr, col0 = u.c0 + wc * 32 + 8 * fq;
#pragma unroll
        for (int ai = 0; ai < 2; ++ai)
#pragma unroll
            for (int m = 0; m < 4; ++m) { const int row = row0 + ai * HALF + m * 16; bf16_t* rowp = O + (size_t)row * ldc + col0; float s = 0.f;
#pragma unroll
                for (int bj = 0; bj < 2; ++bj) { const f32x4 v0 = acc[ai][bj][m][0], v1 = acc[ai][bj][m][1];
                    if (SS) s += (v0[0] * v0[0] + v0[1] * v0[1]) + (v0[2] * v0[2] + v0[3] * v0[3]) + (v1[0] * v1[0] + v1[1] * v1[1]) + (v1[2] * v1[2] + v1[3] * v1[3]);
                    u32x4 w; w.x = cvt_pk_bf16(v0[0], v0[1]); w.y = cvt_pk_bf16(v0[2], v0[3]); w.z = cvt_pk_bf16(v1[0], v1[1]); w.w = cvt_pk_bf16(v1[2], v1[3]);
                    *(u32x4*)(rowp + bj * HALF) = w; }
                if (SS) { s += __shfl_xor(s, 16); s += __shfl_xor(s, 32); if (fq == 0) ssp[(size_t)row * 32 + (u.c0 >> 8) * 4 + wc] = s; } }
    }
};
struct EpiGeluUV {
    bf16_t* U; bf16_t* V; float* vst;
    __device__ __forceinline__ void operator()(const f32x4 (&acc)[2][2][4][2], const GU& u, int wr, int wc, int fr, int fq, LAS unsigned char*) const {
        const bool isv = u.c0 >= DG; const int cbase = isv ? u.c0 - DG : u.c0; bf16_t* O = isv ? V : U;
        const int row0 = u.r0 + wr * 64 + fr, col0 = cbase + wc * 32 + 8 * fq;
#pragma unroll
        for (int ai = 0; ai < 2; ++ai)
#pragma unroll
            for (int m = 0; m < 4; ++m) { const int row = row0 + ai * HALF + m * 16; bf16_t* rowp = O + (size_t)row * DG + col0; float s = 0.f, q = 0.f;
#pragma unroll
                for (int bj = 0; bj < 2; ++bj) { f32x4 v0 = acc[ai][bj][m][0], v1 = acc[ai][bj][m][1];
#pragma unroll
                    for (int e = 0; e < 4; ++e) { v0[e] = gelu_tanh_f(v0[e]); v1[e] = gelu_tanh_f(v1[e]); }
                    s += (v0[0] + v0[1]) + (v0[2] + v0[3]) + (v1[0] + v1[1]) + (v1[2] + v1[3]);
                    q += (v0[0] * v0[0] + v0[1] * v0[1]) + (v0[2] * v0[2] + v0[3] * v0[3]) + (v1[0] * v1[0] + v1[1] * v1[1]) + (v1[2] * v1[2] + v1[3] * v1[3]);
                    u32x4 w; w.x = cvt_pk_bf16(v0[0], v0[1]); w.y = cvt_pk_bf16(v0[2], v0[3]); w.z = cvt_pk_bf16(v1[0], v1[1]); w.w = cvt_pk_bf16(v1[2], v1[3]);
                    *(u32x4*)(rowp + bj * HALF) = w; }
                if (isv) { s += __shfl_xor(s, 16); s += __shfl_xor(s, 32); q += __shfl_xor(q, 16); q += __shfl_xor(q, 32);
                    if (fq == 0) *(f32x2*)(vst + ((size_t)row * 32 + (cbase >> 8) * 4 + wc) * 2) = (f32x2){s, q}; } }
    }
};
struct EpiSwiglu {
    bf16_t* HF;
    __device__ __forceinline__ void operator()(const f32x4 (&acc)[2][2][4][2], const GU& u, int wr, int wc, int fr, int fq, LAS unsigned char*) const {
        const int row0 = u.r0 + wr * 64 + fr, col0 = u.c0 + wc * 32 + 8 * fq;
#pragma unroll
        for (int ai = 0; ai < 2; ++ai)
#pragma unroll
            for (int m = 0; m < 4; ++m) { const int row = row0 + ai * HALF + m * 16; float o[8];
#pragma unroll
                for (int n = 0; n < 2; ++n)
#pragma unroll
                    for (int e = 0; e < 4; ++e) o[n * 4 + e] = silu_f(acc[ai][0][m][n][e]) * acc[ai][1][m][n][e];
                u32x4 w; w.x = cvt_pk_bf16(o[0], o[1]); w.y = cvt_pk_bf16(o[2], o[3]); w.z = cvt_pk_bf16(o[4], o[5]); w.w = cvt_pk_bf16(o[6], o[7]);
                *(u32x4*)(HF + (size_t)row * DFF + col0) = w; }
    }
};
struct EpiSoftmax {
    bf16_t* PT; float* rsp;
    __device__ __forceinline__ void operator()(const f32x4 (&acc)[2][2][4][2], const GU& u, int wr, int wc, int fr, int fq, LAS unsigned char* lds) const {
        LAS float* red = (LAS float*)(lds + RED_OFF);
#pragma unroll
        for (int ai = 0; ai < 2; ++ai)
#pragma unroll
            for (int m = 0; m < 4; ++m) { float mx = -3.0e38f;
#pragma unroll
                for (int bj = 0; bj < 2; ++bj)
#pragma unroll
                    for (int n = 0; n < 2; ++n)
#pragma unroll
                        for (int e = 0; e < 4; ++e) mx = fmaxf(mx, acc[ai][bj][m][n][e]);
                mx = fmaxf(mx, __shfl_xor(mx, 16)); mx = fmaxf(mx, __shfl_xor(mx, 32));
                if (fq == 0) red[(ai * HALF + wr * 64 + m * 16 + fr) * 4 + wc] = mx; }
        asm volatile("s_waitcnt lgkmcnt(0)" ::: "memory"); __builtin_amdgcn_s_barrier(); asm volatile("" ::: "memory");
        const int row0 = u.r0 + wr * 64 + fr, col0 = u.c0 + wc * 32 + 8 * fq;
#pragma unroll
        for (int ai = 0; ai < 2; ++ai)
#pragma unroll
            for (int m = 0; m < 4; ++m) { const int rl = ai * HALF + wr * 64 + m * 16 + fr; const int row = row0 + ai * HALF + m * 16;
                const f32x4 r4 = *(const LAS f32x4*)(red + rl * 4); const float mx = fmaxf(fmaxf(r4[0], r4[1]), fmaxf(r4[2], r4[3])) * 1.4426950408889634f;
                float s = 0.f; bf16_t* rowp = PT + (size_t)row * 1024 + col0;
#pragma unroll
                for (int bj = 0; bj < 2; ++bj) { f32x4 v0 = acc[ai][bj][m][0], v1 = acc[ai][bj][m][1];
#pragma unroll
                    for (int e = 0; e < 4; ++e) { v0[e] = __builtin_amdgcn_exp2f(v0[e] * 1.4426950408889634f - mx); v1[e] = __builtin_amdgcn_exp2f(v1[e] * 1.4426950408889634f - mx); }
                    s += (v0[0] + v0[1]) + (v0[2] + v0[3]) + (v1[0] + v1[1]) + (v1[2] + v1[3]);
                    u32x4 w; w.x = cvt_pk_bf16(v0[0], v0[1]); w.y = cvt_pk_bf16(v0[2], v0[3]); w.z = cvt_pk_bf16(v1[0], v1[1]); w.w = cvt_pk_bf16(v1[2], v1[3]);
                    *(u32x4*)(rowp + bj * HALF) = w; }
                s += __shfl_xor(s, 16); s += __shfl_xor(s, 32);
                if (fq == 0) rsp[(size_t)row * 16 + u.aux * 4 + wc] = s; }
    }
};
struct EpiPV {
    bf16_t* OB; const float* rsp;
    __device__ __forceinline__ void operator()(const f32x4 (&acc)[2][2][4][2], const GU& u, int wr, int wc, int fr, int fq, LAS unsigned char*) const {
        const int row0 = u.r0 + wr * 64 + fr, col0 = u.c0 + wc * 32 + 8 * fq;
#pragma unroll
        for (int ai = 0; ai < 2; ++ai)
#pragma unroll
            for (int m = 0; m < 4; ++m) { const int row = row0 + ai * HALF + m * 16; bf16_t* rowp = OB + (size_t)row * D + col0;
                const f32x4 r4 = *(const f32x4*)(rsp + (size_t)row * 16 + u.aux * 4); const float inv = 1.f / ((r4[0] + r4[1]) + (r4[2] + r4[3]));
#pragma unroll
                for (int bj = 0; bj < 2; ++bj) { const f32x4 v0 = acc[ai][bj][m][0] * inv, v1 = acc[ai][bj][m][1] * inv;
                    u32x4 w; w.x = cvt_pk_bf16(v0[0], v0[1]); w.y = cvt_pk_bf16(v0[2], v0[3]); w.z = cvt_pk_bf16(v1[0], v1[1]); w.w = cvt_pk_bf16(v1[2], v1[3]);
                    *(u32x4*)(rowp + bj * HALF) = w; } }
    }
};

struct Args { const float* in[21]; float* out; unsigned char* ws; };
struct Frame { LAS unsigned char* lds; int tid, lane, wave, vcu; static constexpr int G = GRID; };
__device__ __forceinline__ Frame make_frame(LAS unsigned char* lds) {
    Frame F; F.lds = lds; int t_ = threadIdx.x; asm volatile("" : "+v"(t_)); F.tid = t_; F.lane = F.tid & 63; F.wave = __builtin_amdgcn_readfirstlane(F.tid >> 6);
    int bx = blockIdx.x; asm volatile("" : "+s"(bx)); F.vcu = (bx % 8) * (GRID / 8) + bx / 8; return F; }

__device__ __forceinline__ void tr_item(const float* W, int ldw, int K, const float* kg, const float* ng, float cmul, bf16_t* WT, int blk, int blkstride, int blkoff,
                                        LAS float* scr, int item, int nblk, int lane) {
    const int kb = item / nblk, nb = item % nblk, k0 = 64 * kb, n0 = 32 * nb;
    const float gn = (ng ? ng[n0 + (lane & 31)] : 1.f) * cmul;
#pragma unroll 8
    for (int i = 0; i < 32; ++i) { const int kk = 2 * i + (lane >> 5); const float gk = kg ? kg[k0 + kk] : 1.f;
        scr[kk * 33 + (lane & 31)] = W[(size_t)(k0 + kk) * ldw + n0 + (lane & 31)] * (gk * gn); }
    LDS_WAIT(); asm volatile("" ::: "memory");
    const int c = lane & 7;
    const int rbase = (n0 / blk) * blkstride + blkoff + (n0 % blk);
#pragma unroll
    for (int j = 0; j < 4; ++j) { const int n = (lane >> 3) + 8 * j; const LAS float* s = scr + (8 * c) * 33 + n;
        u32x4 o; o.x = cvt_pk_bf16(s[0 * 33], s[1 * 33]); o.y = cvt_pk_bf16(s[2 * 33], s[3 * 33]); o.z = cvt_pk_bf16(s[4 * 33], s[5 * 33]); o.w = cvt_pk_bf16(s[6 * 33], s[7 * 33]);
        *(u32x4*)(WT + (size_t)(rbase + n) * K + k0 + 8 * c) = o; }
    LDS_WAIT(); asm volatile("" ::: "memory");
}
__device__ __forceinline__ void tr_job(const Frame& F, int& base, const float* W, int ldw, int K, int N, const float* kg, const float* ng, float cmul, bf16_t* WT, int blk, int blkstride, int blkoff) {
    const int NGW = GRID * NWAVES, gw = F.vcu * NWAVES + F.wave;
    LAS float* scr = (LAS float*)(F.lds + F.wave * 16384);
    const int nblk = N / 32, nitems = (K / 64) * nblk;
    int first = (gw - (base % NGW) + NGW) % NGW;
    for (int it = first; it < nitems; it += NGW) tr_item(W, ldw, K, kg, ng, cmul, WT, blk, blkstride, blkoff, scr, it, nblk, F.lane);
    base += nitems;
}

__device__ __forceinline__ void norm_row_to_bf16(const float* src, float* dstx, bf16_t* dstb, int lane) {
    f32x4 v[8]; float ss = 0.f;
#pragma unroll
    for (int j = 0; j < 4; ++j) { const f32x4* p = (const f32x4*)(src + j * 512 + lane * 8); v[2 * j] = p[0]; v[2 * j + 1] = p[1]; }
#pragma unroll
    for (int j = 0; j < 8; ++j) ss += (v[j][0] * v[j][0] + v[j][1] * v[j][1]) + (v[j][2] * v[j][2] + v[j][3] * v[j][3]);
    const float rinv = rsqrtf(wave_sum(ss) * (1.f / D) + EPS);
#pragma unroll
    for (int j = 0; j < 4; ++j) {
        if (dstx) { f32x4* p = (f32x4*)(dstx + j * 512 + lane * 8); p[0] = v[2 * j]; p[1] = v[2 * j + 1]; }
        const f32x4 a = v[2 * j] * rinv, b = v[2 * j + 1] * rinv;
        u32x4 w; w.x = cvt_pk_bf16(a[0], a[1]); w.y = cvt_pk_bf16(a[2], a[3]); w.z = cvt_pk_bf16(b[0], b[1]); w.w = cvt_pk_bf16(b[2], b[3]);
        *(u32x4*)(dstb + j * 512 + lane * 8) = w; }
}

template <bool WRITE_XB>
__device__ __forceinline__ void row_pass(const Frame& F, float* X, const bf16_t* HB, const float* ssp, const float* g, bf16_t* XBp) {
    const int NGW = GRID * NWAVES, gw = F.vcu * NWAVES + F.wave, lane = F.lane;
    f32x4 gv[8];
#pragma unroll
    for (int j = 0; j < 4; ++j) { const f32x4* p = (const f32x4*)(g + j * 512 + lane * 8); gv[2 * j] = p[0]; gv[2 * j + 1] = p[1]; }
    for (int row = gw; row < M; row += NGW) {
        float* xr = X + (size_t)row * D; const bf16_t* hr = HB + (size_t)row * D;
        f32x4 v[8]; u32x4 hw[4];
#pragma unroll
        for (int j = 0; j < 4; ++j) { const f32x4* p = (const f32x4*)(xr + j * 512 + lane * 8); v[2 * j] = p[0]; v[2 * j + 1] = p[1]; hw[j] = *(const u32x4*)(hr + j * 512 + lane * 8); }
        const float part = lane < 32 ? ssp[(size_t)row * 32 + lane] : 0.f;
        const float rh = rsqrtf(wave_sum(part) * (1.f / D) + EPS);
        float ss = 0.f;
#pragma unroll
        for (int j = 0; j < 4; ++j) {
            f32x4 h0 = (f32x4){bf_lo(hw[j].x), bf_hi(hw[j].x), bf_lo(hw[j].y), bf_hi(hw[j].y)}, h1 = (f32x4){bf_lo(hw[j].z), bf_hi(hw[j].z), bf_lo(hw[j].w), bf_hi(hw[j].w)};
            v[2 * j] = v[2 * j] + h0 * rh * gv[2 * j]; v[2 * j + 1] = v[2 * j + 1] + h1 * rh * gv[2 * j + 1];
            f32x4* p = (f32x4*)(xr + j * 512 + lane * 8); p[0] = v[2 * j]; p[1] = v[2 * j + 1];
            ss += (v[2 * j][0] * v[2 * j][0] + v[2 * j][1] * v[2 * j][1]) + (v[2 * j][2] * v[2 * j][2] + v[2 * j][3] * v[2 * j][3]);
            ss += (v[2 * j + 1][0] * v[2 * j + 1][0] + v[2 * j + 1][1] * v[2 * j + 1][1]) + (v[2 * j + 1][2] * v[2 * j + 1][2] + v[2 * j + 1][3] * v[2 * j + 1][3]); }
        if (WRITE_XB) {
            const float rinv = rsqrtf(wave_sum(ss) * (1.f / D) + EPS); bf16_t* br = XBp + (size_t)row * D;
#pragma unroll
            for (int j = 0; j < 4; ++j) { const f32x4 a = v[2 * j] * rinv, b = v[2 * j + 1] * rinv;
                u32x4 w; w.x = cvt_pk_bf16(a[0], a[1]); w.y = cvt_pk_bf16(a[2], a[3]); w.z = cvt_pk_bf16(b[0], b[1]); w.w = cvt_pk_bf16(b[2], b[3]);
                *(u32x4*)(br + j * 512 + lane * 8) = w; } }
    }
}

__device__ __forceinline__ void ld8(const bf16_t* p, float (&o)[8]) { const u32x4 w = *(const u32x4*)p; o[0] = bf_lo(w.x); o[1] = bf_hi(w.x); o[2] = bf_lo(w.y); o[3] = bf_hi(w.y); o[4] = bf_lo(w.z); o[5] = bf_hi(w.z); o[6] = bf_lo(w.w); o[7] = bf_hi(w.w); }
__device__ __forceinline__ void pool_pre(const Frame& F, const bf16_t* XBp, bf16_t* DA) {
    const int gt = F.vcu * NTHREADS + F.tid, NT = GRID * NTHREADS;
    for (int it = gt; it < (M / 16) * (D / 8); it += NT) {
        const int cc = it % (D / 8), rb = it / (D / 8); const int half = 1 << (cc >> 6);
        const int r0 = rb * 16, t0 = r0 % SEQ; const bf16_t* base = XBp + (size_t)(r0 - t0) * D + cc * 8;
        float s[8];
#pragma unroll
        for (int e = 0; e < 8; ++e) s[e] = 0.f;
        for (int tt = t0 - half; tt < t0 + half - 1; ++tt) if (tt >= 0 && tt < SEQ) { float v[8]; ld8(base + (size_t)tt * D, v);
#pragma unroll
            for (int e = 0; e < 8; ++e) s[e] += v[e]; }
        for (int t = t0; t < t0 + 16; ++t) {
            const int ta = t + half - 1;
            if (ta < SEQ) { float v[8]; ld8(base + (size_t)ta * D, v);
#pragma unroll
                for (int e = 0; e < 8; ++e) s[e] += v[e]; }
            const int lo = t - half > 0 ? t - half : 0, hi = t + half < SEQ ? t + half : SEQ; const float ic = 1.f / (float)(hi - lo);
            float c[8], o[8]; ld8(base + (size_t)t * D, c);
#pragma unroll
            for (int e = 0; e < 8; ++e) o[e] = s[e] * ic - c[e];
            u32x4 w; w.x = cvt_pk_bf16(o[0], o[1]); w.y = cvt_pk_bf16(o[2], o[3]); w.z = cvt_pk_bf16(o[4], o[5]); w.w = cvt_pk_bf16(o[6], o[7]);
            *(u32x4*)(DA + (size_t)(r0 - t0 + t) * D + cc * 8) = w;
            const int ts = t - half;
            if (ts >= 0) { float v[8]; ld8(base + (size_t)ts * D, v);
#pragma unroll
                for (int e = 0; e < 8; ++e) s[e] -= v[e]; }
        }
    }
}

__device__ __forceinline__ int tswz(int c) { return ((c & 3) ^ ((((c >> 3) ^ (c >> 7)) & 1) | (((c >> 6) & 1) << 1))) | (((c >> 4) & 3) << 2); }
__device__ __forceinline__ void spatial_phase(const Frame& F, const bf16_t* U, const bf16_t* V, const float* vst, const bf16_t* Wsb, const float* bs, const float* lng, const float* lnb, bf16_t* GATED) {
    LAS unsigned char* T = F.lds; LAS f32x2* st = (LAS f32x2*)(F.lds + 65536);
    const int tid = F.tid, lane = F.lane, w = F.wave;
    for (int idx = F.vcu; idx < (M / 128) * 8; idx += GRID) {
        const int chunk = idx >> 3, head = idx & 7; const size_t rowb = (size_t)chunk * 128;
        __syncthreads();
        if (tid < 128) { const f32x4* p = (const f32x4*)(vst + (rowb + tid) * 64); float s = 0.f, q = 0.f;
#pragma unroll
            for (int i = 0; i < 16; ++i) { const f32x4 x = p[i]; s += x[0] + x[2]; q += x[1] + x[3]; }
            const float mu = s * (1.f / DG); const float var = q * (1.f / DG) - mu * mu; st[tid] = (f32x2){mu, rsqrtf(fmaxf(var, 0.f) + EPS)}; }
        __syncthreads();
        {
            const int c8 = (tid & 31) * 8, qg = tid >> 5; float lg[8], lb[8];
#pragma unroll
            for (int e = 0; e < 8; ++e) { lg[e] = lng[head * 256 + c8 + e]; lb[e] = lnb[head * 256 + c8 + e]; }
            float x[8][8];
#pragma unroll
            for (int r = 0; r < 8; ++r) { const int q = qg * 8 + r; float v[8]; ld8(V + (rowb + q) * DG + head * 256 + c8, v); const f32x2 ms = st[q];
#pragma unroll
                for (int e = 0; e < 8; ++e) x[r][e] = (v[e] - ms.x) * ms.y * lg[e] + lb[e]; }
#pragma unroll
            for (int e = 0; e < 8; ++e) { const int c = c8 + e; u32x4 wv; wv.x = cvt_pk_bf16(x[0][e], x[1][e]); wv.y = cvt_pk_bf16(x[2][e], x[3][e]); wv.z = cvt_pk_bf16(x[4][e], x[5][e]); wv.w = cvt_pk_bf16(x[6][e], x[7][e]);
                *(LAS u32x4*)(T + c * 256 + ((qg ^ tswz(c)) << 4)) = wv; }
        }
        bf16x8 wf[4];
#pragma unroll
        for (int ks = 0; ks < 4; ++ks) wf[ks] = *(const bf16x8*)(Wsb + ((size_t)head * 128 + 16 * w + (lane & 15)) * 128 + ks * 32 + (lane >> 4) * 8);
        __syncthreads();
        f32x4 acc[16];
#pragma unroll
        for (int nb = 0; nb < 16; ++nb) acc[nb] = (f32x4){0.f, 0.f, 0.f, 0.f};
        const int s = lane & 15, kq = lane >> 4;
#pragma unroll
        for (int nb = 0; nb < 16; ++nb) { const int c = 64 * (nb >> 2) + 16 * (s >> 2) + 4 * (nb & 3) + (s & 3); const int sw = tswz(c);
#pragma unroll
            for (int ks = 0; ks < 4; ++ks) { const bf16x8 tf = *(const LAS bf16x8*)(T + c * 256 + (((ks * 4 + kq) ^ sw) << 4));
                acc[nb] = __builtin_amdgcn_mfma_f32_16x16x32_bf16(tf, wf[ks], acc[nb], 0, 0, 0); } }
        const int p = 16 * w + (lane & 15), g4 = lane >> 4; const float bias = bs[head * 128 + p];
        const size_t orow = (rowb + p) * DG + head * 256;
#pragma unroll
        for (int a = 0; a < 4; ++a) { float ua[8], ub[8]; ld8(U + orow + 64 * a + 16 * g4, ua); ld8(U + orow + 64 * a + 16 * g4 + 8, ub);
            float o[16];
#pragma unroll
            for (int b = 0; b < 2; ++b)
#pragma unroll
                for (int e = 0; e < 4; ++e) { o[4 * b + e] = ua[4 * b + e] * (acc[4 * a + b][e] + bias); o[8 + 4 * b + e] = ub[4 * b + e] * (acc[4 * a + 2 + b][e] + bias); }
            u32x4 w0, w1; w0.x = cvt_pk_bf16(o[0], o[1]); w0.y = cvt_pk_bf16(o[2], o[3]); w0.z = cvt_pk_bf16(o[4], o[5]); w0.w = cvt_pk_bf16(o[6], o[7]);
            w1.x = cvt_pk_bf16(o[8], o[9]); w1.y = cvt_pk_bf16(o[10], o[11]); w1.z = cvt_pk_bf16(o[12], o[13]); w1.w = cvt_pk_bf16(o[14], o[15]);
            *(u32x4*)(GATED + orow + 64 * a + 16 * g4) = w0; *(u32x4*)(GATED + orow + 64 * a + 16 * g4 + 8) = w1; }
    }
    __syncthreads();
}

__device__ __forceinline__ const __attribute__((address_space(4))) Args* kargs() {
    const __attribute__((address_space(4))) Args* p = (const __attribute__((address_space(4))) Args*)__builtin_amdgcn_kernarg_segment_ptr();
    asm volatile("" : "+s"(p));
    return p;
}
#define KIN(k) (kargs()->in[k])
#define WSP(off) (kargs()->ws + (off))
#define x_prompt KIN(0)
#define x_sample KIN(1)
#define mem_prompt KIN(2)
#define mem_sample KIN(3)
#define norm_gains KIN(4)
#define mem_norm KIN(5)
#define pool_w KIN(6)
#define pool_scale KIN(7)
#define gmlp_w_in KIN(8)
#define gmlp_ln_g KIN(9)
#define gmlp_ln_b KIN(10)
#define gmlp_w_s KIN(11)
#define gmlp_b_s KIN(12)
#define gmlp_w_out KIN(13)
#define attn_wq KIN(14)
#define attn_wk KIN(15)
#define attn_wv KIN(16)
#define attn_wo KIN(17)
#define ffn_w_gate KIN(18)
#define ffn_w_up KIN(19)
#define ffn_w_down KIN(20)
#define X (kargs()->out)
#define WPOOL ((bf16_t*)WSP(WS_WPOOL))
#define WSB ((bf16_t*)WSP(WS_WS))
#define WIN ((bf16_t*)WSP(WS_WIN))
#define WOUT ((bf16_t*)WSP(WS_WOUT))
#define WQ ((bf16_t*)WSP(WS_WQ))
#define WK ((bf16_t*)WSP(WS_WK))
#define WV ((bf16_t*)WSP(WS_WV))
#define WO ((bf16_t*)WSP(WS_WO))
#define WGU ((bf16_t*)WSP(WS_WGU))
#define WDN ((bf16_t*)WSP(WS_WDN))
#define MEMBN ((bf16_t*)WSP(WS_MEMBN))
#define KMAT ((bf16_t*)WSP(WS_KMAT))
#define VT ((bf16_t*)WSP(WS_VT))
#define XB ((bf16_t*)WSP(WS_XB))
#define HB ((bf16_t*)WSP(WS_HB))
#define SSP ((float*)WSP(WS_SSP))
#define VST ((float*)WSP(WS_VST))
#define RSP ((float*)WSP(WS_RSP))
#define UB ((bf16_t*)WSP(WS_BIG + BIG_U))
#define VB ((bf16_t*)WSP(WS_BIG + BIG_V))
#define DA ((bf16_t*)WSP(WS_BIG + BIG_DA))
#define QB ((bf16_t*)WSP(WS_BIG + BIG_Q))
#define OB ((bf16_t*)WSP(WS_BIG + BIG_O))
#define PT ((bf16_t*)WSP(WS_BIG + BIG_PT))
#define HF ((bf16_t*)WSP(WS_BIG + BIG_HF))
#define GATED XB

#define GRID_BAR() do { XcdBarrier _b; _b.bar = (unsigned*)WSP(WS_CTL) + CW_BAR; _b.x = xb_xcc_id(); _b.st = (volatile LAS unsigned*)(lds + MISC_OFF) + 8; xcd_barrier(_b); } while (0)
#define MK_STEP (size_t)BM * D * 2
__global__ void __launch_bounds__(NTHREADS, 2) mega_fwd(Args args) {
    extern __shared__ __attribute__((aligned(16))) unsigned char lds_raw[];
    LAS unsigned char* const lds = (LAS unsigned char*)lds_raw; (void)args;
    if (gridDim.x != GRID) return;
    { volatile LAS unsigned* MISC = (volatile LAS unsigned*)(lds + MISC_OFF); if (threadIdx.x < 32) MISC[threadIdx.x] = 0u; __syncthreads();
      (void)xcd_barrier_post((unsigned*)WSP(WS_CTL) + CW_BAR, MISC + 8); }

    {
        const Frame F = make_frame(lds); const int NGW = GRID * NWAVES, gw = F.vcu * NWAVES + F.wave;
        int base = 0;
        if (PH(0)) for (int i = 0; i < DEPTH; ++i) {
            const float* g = norm_gains + (size_t)i * 6 * D;
            tr_job(F, base, attn_wq + (size_t)i * D * D, D, D, D, g + 2 * D, nullptr, 0.04419417382415922f, WQ + (size_t)i * D * D, D, D, 0);
            tr_job(F, base, attn_wk + (size_t)i * D * D, D, D, D, mem_norm + (size_t)i * D, nullptr, 1.f, WK + (size_t)i * D * D, D, D, 0);
            tr_job(F, base, attn_wv + (size_t)i * D * D, D, D, D, mem_norm + (size_t)i * D, nullptr, 1.f, WV + (size_t)i * D * D, D, D, 0);
            tr_job(F, base, attn_wo + (size_t)i * D * D, D, D, D, nullptr, nullptr, 1.f, WO + (size_t)i * D * D, D, D, 0);
            tr_job(F, base, ffn_w_gate + (size_t)i * D * DFF, DFF, D, DFF, g + 4 * D, nullptr, 1.f, WGU + (size_t)i * 2 * DFF * D, 128, 256, 0);
            tr_job(F, base, ffn_w_up + (size_t)i * D * DFF, DFF, D, DFF, g + 4 * D, nullptr, 1.f, WGU + (size_t)i * 2 * DFF * D, 128, 256, 128);
            tr_job(F, base, ffn_w_down + (size_t)i * DFF * D, D, DFF, D, nullptr, nullptr, 1.f, WDN + (size_t)i * D * DFF, D, D, 0);
        }
        if (PH(0)) for (int j = 0; j < 2; ++j) {
            const float* g0p = norm_gains + (size_t)(2 * j) * 6 * D;
            const float* g0g = norm_gains + (size_t)(2 * j + 1) * 6 * D;
            for (int gq = 0; gq < 4; ++gq)
                tr_job(F, base, pool_w + ((size_t)j * 4 + gq) * 512 * 512, 512, 512, 512, g0p + gq * 512, pool_scale + (size_t)j * D + gq * 512, 1.f, WPOOL + ((size_t)j * 4 + gq) * 512 * 512, 512, 512, 0);
            tr_job(F, base, gmlp_w_in + (size_t)j * D * 2 * DG, 2 * DG, D, 2 * DG, g0g, nullptr, 1.f, WIN + (size_t)j * 2 * DG * D, 2 * DG, 2 * DG, 0);
            tr_job(F, base, gmlp_w_out + (size_t)j * DG * D, D, DG, D, nullptr, nullptr, 1.f, WOUT + (size_t)j * D * DG, D, D, 0);
        }
        if (PH(1)) for (int i = (F.vcu * NTHREADS + F.tid) * 8; i < 2 * 8 * 128 * 128; i += GRID * NTHREADS * 8) { const f32x4 a = *(const f32x4*)(gmlp_w_s + i), b = *(const f32x4*)(gmlp_w_s + i + 4);
            u32x4 w; w.x = cvt_pk_bf16(a[0], a[1]); w.y = cvt_pk_bf16(a[2], a[3]); w.z = cvt_pk_bf16(b[0], b[1]); w.w = cvt_pk_bf16(b[2], b[3]); *(u32x4*)(WSB + i) = w; }
        if (PH(1)) for (int r = gw; r < MM; r += NGW) { const float* src = r < NPROMPT_MEM ? mem_prompt + (size_t)r * D : mem_sample + (size_t)(r - NPROMPT_MEM) * D; norm_row_to_bf16(src, nullptr, MEMBN + (size_t)r * D, F.lane); }
        if (PH(1)) for (int r = gw; r < M; r += NGW) { const float* src = r < NPROMPT_ROWS ? x_prompt + (size_t)r * D : x_sample + (size_t)(r - NPROMPT_ROWS) * D; norm_row_to_bf16(src, X + (size_t)r * D, XB + (size_t)r * D, F.lane); }
    }
    GRID_BAR();
    if (PH(2)) {
        MapReg<MM / BM, (4 * D) / BM, BM> mp; mp.A = (const char*)MEMBN; mp.B = (const char*)WK; mp.astep = MK_STEP; mp.bstep = MK_STEP;
        EpiPlain<false> E{KMAT, 4 * D, nullptr};
        gemm_phase<EpiPlain<false>, MapReg<MM / BM, (4 * D) / BM, BM>, false>(lds, mp, E, D, D, D);
    }
    if (PH(2)) {
        MapReg<(4 * D) / BM, MM / BM, BM> mp; mp.A = (const char*)WV; mp.B = (const char*)MEMBN; mp.astep = MK_STEP; mp.bstep = MK_STEP;
        EpiPlain<false> E{VT, MM, nullptr};
        gemm_phase<EpiPlain<false>, MapReg<(4 * D) / BM, MM / BM, BM>, false>(lds, mp, E, D, D, D);
    }
    GRID_BAR();

    for (int layer = 0; layer < DEPTH; ++layer) {
        if ((layer & 1) == 0) {
            if (PH(3)) pool_pre(make_frame(lds), XB, DA);
            GRID_BAR();
            if (PH(4)) {   MapPool mp; mp.A = (const char*)DA; mp.B = (const char*)(WPOOL + (size_t)(layer >> 1) * 4 * 512 * 512);
                EpiPlain<true> E{HB, D, SSP};
                gemm_phase<EpiPlain<true>, MapPool, false>(lds, mp, E, 512, D, 512); }
            GRID_BAR();
        } else {
            if (PH(5)) {   MapReg<M / BM, (2 * DG) / BM, BM> mp; mp.A = (const char*)XB; mp.B = (const char*)(WIN + (size_t)(layer >> 1) * 2 * DG * D); mp.astep = MK_STEP; mp.bstep = MK_STEP;
                EpiGeluUV E{UB, VB, VST};
                gemm_phase<EpiGeluUV, MapReg<M / BM, (2 * DG) / BM, BM>, false>(lds, mp, E, D, D, D); }
            GRID_BAR();
            if (PH(6)) { const int j = layer >> 1; spatial_phase(make_frame(lds), UB, VB, VST, WSB + (size_t)j * 8 * 128 * 128, gmlp_b_s + (size_t)j * 8 * 128, gmlp_ln_g + (size_t)j * DG, gmlp_ln_b + (size_t)j * DG, GATED); }
            GRID_BAR();
            if (PH(7)) {   MapReg<M / BM, D / BM, BM> mp; mp.A = (const char*)GATED; mp.B = (const char*)(WOUT + (size_t)(layer >> 1) * D * DG); mp.astep = MK_STEP; mp.bstep = MK_STEP;
                EpiPlain<true> E{HB, D, SSP};
                gemm_phase<EpiPlain<true>, MapReg<M / BM, D / BM, BM>, false>(lds, mp, E, DG, DG, DG); }
            GRID_BAR();
        }
        if (PH(8)) row_pass<true>(make_frame(lds), X, HB, SSP, norm_gains + ((size_t)layer * 6 + 1) * D, XB);
        GRID_BAR();
        if (PH(9)) {   MapReg<M / BM, D / BM, BM> mp; mp.A = (const char*)XB; mp.B = (const char*)(WQ + (size_t)layer * D * D); mp.astep = MK_STEP; mp.bstep = MK_STEP;
            EpiPlain<false> E{QB, D, nullptr};
            gemm_phase<EpiPlain<false>, MapReg<M / BM, D / BM, BM>, false>(lds, mp, E, D, D, D); }
        GRID_BAR();
        if (PH(10)) {   MapS mp; mp.Q = (const char*)QB; mp.Kl = (const char*)(KMAT + (size_t)layer * D);
            EpiSoftmax E{PT, RSP};
            gemm_phase<EpiSoftmax, MapS, true>(lds, mp, E, HD, D, 4 * D); }
        GRID_BAR();
        if (PH(11)) {   MapPV mp; mp.P = (const char*)PT; mp.Vl = (const char*)(VT + (size_t)layer * D * MM);
            EpiPV E{OB, RSP};
            gemm_phase<EpiPV, MapPV, false>(lds, mp, E, NMEM, 1024, MM); }
        GRID_BAR();
        if (PH(12)) {   MapReg<M / BM, D / BM, BM> mp; mp.A = (const char*)OB; mp.B = (const char*)(WO + (size_t)layer * D * D); mp.astep = MK_STEP; mp.bstep = MK_STEP;
            EpiPlain<true> E{HB, D, SSP};
            gemm_phase<EpiPlain<true>, MapReg<M / BM, D / BM, BM>, false>(lds, mp, E, D, D, D); }
        GRID_BAR();
        if (PH(8)) row_pass<true>(make_frame(lds), X, HB, SSP, norm_gains + ((size_t)layer * 6 + 3) * D, XB);
        GRID_BAR();
        if (PH(13)) {   MapReg<M / BM, (2 * DFF) / BM, 128> mp; mp.A = (const char*)XB; mp.B = (const char*)(WGU + (size_t)layer * 2 * DFF * D); mp.astep = MK_STEP; mp.bstep = MK_STEP;
            EpiSwiglu E{HF};
            gemm_phase<EpiSwiglu, MapReg<M / BM, (2 * DFF) / BM, 128>, false>(lds, mp, E, D, D, D); }
        GRID_BAR();
        if (PH(14)) {   MapReg<M / BM, D / BM, BM> mp; mp.A = (const char*)HF; mp.B = (const char*)(WDN + (size_t)layer * D * DFF); mp.astep = (size_t)BM * DFF * 2; mp.bstep = (size_t)BM * DFF * 2;
            EpiPlain<true> E{HB, D, SSP};
            gemm_phase<EpiPlain<true>, MapReg<M / BM, D / BM, BM>, false>(lds, mp, E, DFF, DFF, DFF); }
        GRID_BAR();
        if (layer < DEPTH - 1) { if (PH(8)) row_pass<true>(make_frame(lds), X, HB, SSP, norm_gains + ((size_t)layer * 6 + 5) * D, XB); GRID_BAR(); }
        else if (PH(15)) row_pass<false>(make_frame(lds), X, HB, SSP, norm_gains + ((size_t)layer * 6 + 5) * D, XB);
    }
}
}

static void mk_launch(void* const* d_in, void* d_out, void* d_ws, size_t ws_size, hipStream_t stream) {
    static int ok = 0;
    if (ok == 0) {
        ok = -1;
        if (ws_size < mk::WS_END) { fprintf(stderr, "kernel_launch: workspace too small (%zu < %zu)\n", ws_size, (size_t)mk::WS_END); return; }
        if (hipFuncSetAttribute((const void*)mk::mega_fwd, hipFuncAttributeMaxDynamicSharedMemorySize, mk::LDS_BYTES) != hipSuccess) { fprintf(stderr, "kernel_launch: hipFuncSetAttribute failed\n"); return; }
        int dev = 0, cus = 0, per_cu = 0;
        (void)hipGetDevice(&dev); (void)hipDeviceGetAttribute(&cus, hipDeviceAttributeMultiprocessorCount, dev);
        (void)hipOccupancyMaxActiveBlocksPerMultiprocessor(&per_cu, (const void*)mk::mega_fwd, mk::NTHREADS, mk::LDS_BYTES);
        (void)hipGetLastError();
        if (cus < mk::GRID || per_cu < 1) { fprintf(stderr, "kernel_launch: needs %d CUs with one resident block each (cus %d, per_cu %d)\n", mk::GRID, cus, per_cu); return; }
        ok = 1;
    }
    if (ok < 0) return;
    (void)hipMemsetAsync((char*)d_ws + mk::WS_CTL, 0, mk::CTL_BYTES, stream);
    mk::Args a{};
    for (int i = 0; i < 21; ++i) a.in[i] = (const float*)d_in[i];
    a.out = (float*)d_out; a.ws = (unsigned char*)d_ws;
    hipLaunchKernelGGL(mk::mega_fwd, dim3(mk::GRID), dim3(mk::NTHREADS), mk::LDS_BYTES, stream, a);
}

extern "C" void kernel_launch(void* const* d_in, const int* in_sizes, int n_in, void* d_out, int out_size, void* d_ws, size_t ws_size, hipStream_t stream) {
    (void)in_sizes; (void)n_in; (void)out_size;
    mk_launch(d_in, d_out, d_ws, ws_size, stream);
}
```

```cpp
#include <hip/hip_runtime.h>
#include <cstdio>
#include <cstdint>

namespace mk {
#define LAS __attribute__((address_space(3)))
#define GAS __attribute__((address_space(1)))
typedef unsigned short bf16_t;
typedef short bf16x8 __attribute__((ext_vector_type(8)));
typedef float f32x4 __attribute__((ext_vector_type(4)));
typedef float f32x2 __attribute__((ext_vector_type(2)));
typedef unsigned u32x4 __attribute__((ext_vector_type(4)));
typedef unsigned u32x2 __attribute__((ext_vector_type(2)));

constexpr int D = 2048, SEQ = 2048, NB = 12, M = NB * SEQ, DEPTH = 4, NMEM = 256, MM = NB * NMEM, DFF = 5632, NH = 4, HD = 512, DG = 2048;
constexpr int NPROMPT_ROWS = 4 * SEQ, NPROMPT_MEM = 4 * NMEM;
constexpr float EPS = 1e-6f;
constexpr int NWAVES = 8, NTHREADS = 512, GRID = 256;
#ifndef PHASES
#define PHASES 0xFFFFF
#endif
#define PH(b) ((PHASES >> (b)) & 1)
#ifndef MK_ALIGN
#define MK_ALIGN false
#endif
#ifndef BARX2
#define BARX2 0
#endif
#ifndef ROWPROBE
#define ROWPROBE 0
#endif
#ifndef REPEAT
#define REPEAT 0
#endif
#define REP(b) for (int _r = 0; _r < 1 + ((REPEAT >> (b)) & 1); ++_r)

constexpr size_t MiB = 1u << 20;
constexpr size_t WS_CTL = 0, CTL_BYTES = 1 * MiB;
constexpr size_t WS_WPOOL = 1 * MiB;
constexpr size_t WS_WS = WS_WPOOL + 4 * MiB;
constexpr size_t WS_WIN = WS_WS + 1 * MiB;
constexpr size_t WS_WOUT = WS_WIN + 32 * MiB;
constexpr size_t WS_WQ = WS_WOUT + 16 * MiB;
constexpr size_t WS_WK = WS_WQ + 32 * MiB;
constexpr size_t WS_WV = WS_WK + 32 * MiB;
constexpr size_t WS_WO = WS_WV + 32 * MiB;
constexpr size_t WS_WGU = WS_WO + 32 * MiB;
constexpr size_t WS_WDN = WS_WGU + 176 * MiB;
constexpr size_t WS_MEMBN = WS_WDN + 88 * MiB;
constexpr size_t WS_KMAT = WS_MEMBN + 12 * MiB;
constexpr size_t WS_VT = WS_KMAT + 48 * MiB;
constexpr size_t WS_XB = WS_VT + 48 * MiB;
constexpr size_t WS_HB = WS_XB + 96 * MiB;
constexpr size_t WS_BIG = WS_HB + 96 * MiB;
constexpr size_t WS_SSP = WS_BIG + 264 * MiB;
constexpr size_t WS_VST = WS_SSP + 3 * MiB;
constexpr size_t WS_RSP = WS_VST + 6 * MiB;
constexpr size_t WS_RINV = WS_RSP + 2 * MiB;
constexpr size_t WS_END = WS_RINV + 1 * MiB;
constexpr size_t BIG_U = 0, BIG_V = 96 * MiB, BIG_DA = 0, BIG_Q = 0, BIG_O = 96 * MiB, BIG_PT = 192 * MiB, BIG_HF = 0;
constexpr int CW_BAR = 4096;

constexpr int RING_BYTES = 131072, RED_OFF = RING_BYTES, RED_BYTES = 4096, MISC_OFF = RED_OFF + RED_BYTES, LDS_BYTES = 147456;

#define LDS_WAIT() asm volatile("s_waitcnt lgkmcnt(0)" ::: "memory")
#define VM_WAIT() asm volatile("s_waitcnt vmcnt(0)" ::: "memory")

#define XB_TMO      128
#define XB_XCNT(j)  (256  + 64 * (j))
#define XB_XSUB(j)  (1280 + 64 * (j))
#define XB_XGEN(j)  (2304 + 64 * (j))
#define XB_TOP      3328
#define XB_TOPGEN   3392
#define XCD_BAR_WORDS 3456
#define XB_SPIN_CAP (1u << 18)
__device__ __forceinline__ unsigned xb_ld(unsigned* p)              { return __hip_atomic_load(p, __ATOMIC_RELAXED, __HIP_MEMORY_SCOPE_AGENT); }
__device__ __forceinline__ unsigned xb_add(unsigned* p, unsigned v) { return __hip_atomic_fetch_add(p, v, __ATOMIC_RELAXED, __HIP_MEMORY_SCOPE_AGENT); }
__device__ __forceinline__ unsigned xb_xcc_id() { return (unsigned)__builtin_amdgcn_s_getreg((3 << 11) | 20) & 0xFu; }
#define XB_SPIN(cond, bar) do { unsigned _sp = 0; while (cond) { __builtin_amdgcn_s_sleep(1); \
    if ((++_sp & 255u) == 0u) { if (xb_ld(&(bar)[XB_TMO])) break; if (_sp > XB_SPIN_CAP) { atomicAdd(&(bar)[XB_TMO], 1u); break; } } } } while (0)
struct XcdBarrier { unsigned* bar; unsigned x; volatile LAS unsigned* st; };
__device__ __forceinline__ XcdBarrier xcd_barrier_post(unsigned* bar, volatile LAS unsigned* st) {
    XcdBarrier b; b.bar = bar; b.x = xb_xcc_id(); b.st = st;
    if (threadIdx.x == 0) (void)xb_add(&bar[XB_XCNT(b.x)], 1u);
    return b;
}
__device__ __forceinline__ void xcd_barrier_complete(unsigned* bar, unsigned x, unsigned& nloc, unsigned& nx) {
    const unsigned G = gridDim.x * gridDim.y * gridDim.z;
    unsigned sum, cnt, mine, sp = 0u;
    for (;;) {
        sum = 0u; cnt = 0u; mine = 0u;
#pragma unroll
        for (unsigned j = 0; j < 16; ++j) { const unsigned c = xb_ld(&bar[XB_XCNT(j)]); sum += c; cnt += (c > 0u) ? 1u : 0u; mine = (j == x) ? c : mine; }
        if (sum == G) break;
        __builtin_amdgcn_s_sleep(1);
        if ((++sp & 255u) == 0u) { if (xb_ld(&bar[XB_TMO])) break; if (sp > XB_SPIN_CAP) { atomicAdd(&bar[XB_TMO], 1u); break; } }
    }
    nloc = mine > 0u ? mine : 1u; nx = cnt > 0u ? cnt : 1u;
}
__device__ __forceinline__ void xcd_barrier(const XcdBarrier& b) {
    asm volatile("s_waitcnt vmcnt(0)" ::: "memory");
    __syncthreads();
    if (threadIdx.x == 0) {
        unsigned* bar = b.bar;
        __builtin_amdgcn_s_waitcnt(0);
        unsigned nloc = b.st[0], nx = b.st[1];
        if (nloc == 0u) { xcd_barrier_complete(bar, b.x, nloc, nx); b.st[0] = nloc; b.st[1] = nx; }
        const unsigned old = xb_add(&bar[XB_XSUB(b.x)], 1u);
        const unsigned gen = old / nloc;
        if (old + 1u == (gen + 1u) * nloc) {
            __builtin_amdgcn_fence(__ATOMIC_RELEASE, "agent");
            asm volatile("s_waitcnt vmcnt(0)" ::: "memory");
            const unsigned og = xb_add(&bar[XB_TOP], 1u);
            const unsigned tg = og / nx;
            if (og + 1u == (tg + 1u) * nx) xb_add(&bar[XB_TOPGEN], 1u);
            else XB_SPIN(xb_ld(&bar[XB_TOPGEN]) == tg, bar);
            __builtin_amdgcn_fence(__ATOMIC_ACQUIRE, "agent");
            xb_add(&bar[XB_XGEN(b.x)], 1u);
            asm volatile("s_waitcnt vmcnt(0)" ::: "memory");
        } else {
            XB_SPIN(xb_ld(&bar[XB_XGEN(b.x)]) == gen, bar);
            __builtin_amdgcn_fence(__ATOMIC_ACQUIRE, "agent");
            asm volatile("s_waitcnt vmcnt(0)" ::: "memory");
        }
    }
    __syncthreads();
}

__device__ __forceinline__ unsigned cvt_pk_bf16(float lo, float hi) { unsigned r; asm volatile("v_cvt_pk_bf16_f32 %0, %1, %2" : "=v"(r) : "v"(lo), "v"(hi)); return r; }
__device__ __forceinline__ float bf_lo(unsigned w) { return __uint_as_float(w << 16); }
__device__ __forceinline__ float bf_hi(unsigned w) { return __uint_as_float(w & 0xffff0000u); }
__device__ __forceinline__ float wave_sum(float v) {
#pragma unroll
    for (int o = 1; o < 64; o <<= 1) v += __shfl_xor(v, o);
    return v;
}
__device__ __forceinline__ float fast_exp(float x) { return __builtin_amdgcn_exp2f(x * 1.4426950408889634f); }
__device__ __forceinline__ float gelu_tanh_f(float x) {
    const float u = x * (1.5957691216057308f + 0.07135481282803448f * x * x);
    return x * __builtin_amdgcn_rcpf(1.f + fast_exp(-u));
}
__device__ __forceinline__ float silu_f(float x) { return x * __builtin_amdgcn_rcpf(1.f + fast_exp(-x)); }

constexpr int BM = 256, BK = 64, HALF = 128, HTB = HALF * BK * 2, NXCD = 8, WGM = 8;
__device__ __forceinline__ int lds_byte(int r, int c) { const int st = (r >> 4) * 2 + (c >> 5), rr = r & 15, cc = c & 31, ob = rr * 64 + cc * 2; return st * 1024 + (ob ^ (((ob >> 9) & 1) << 5)); }
__device__ __forceinline__ void stage_rc(int b, int& R, int& C) { const int st = b / 1024, sb = b % 1024, swz = sb ^ (((sb >> 9) & 1) << 5); R = (st >> 1) * 16 + swz / 64; C = (st & 1) * 32 + (swz % 64) / 2; }
__device__ __forceinline__ int perm32(int rho) { const int n = rho >> 4, i = rho & 15; return 8 * (i >> 2) + 4 * n + (i & 3); }

struct GU { const char* A; const char* B; int r0, c0, aux; };
struct Tile { int pm, pn; };
template <int nM, int nN> struct Order {
    static constexpr int nwg = nM * nN, G = GRID;
    __device__ __forceinline__ bool tile(int i, Tile& t) const {
        int c = (int)blockIdx.x; asm volatile("" : "+s"(c));
        const long L = (long)i * G + c; if (L >= nwg) return false;
        int wgid = (int)L; { const int q = nwg / NXCD, r = nwg % NXCD, xcd = wgid % NXCD, off = wgid / NXCD; wgid = (xcd < r ? xcd * (q + 1) : r * (q + 1) + (xcd - r) * q) + off; }
        const int nig = WGM * nN, gid = wgid / nig, fm = gid * WGM, gsz = (nM - fm) < WGM ? (nM - fm) : WGM;
        t.pm = fm + ((wgid % nig) % gsz); t.pn = (wgid % nig) / gsz; return true;
    }
};
template <class Epi, class Map, bool ALIGN_EPI>
__device__ __forceinline__ void gemm_phase(LAS unsigned char* lds, const Map& S, const Epi& E, const int K, const int lda, const int ldb) {
    int tid_ = threadIdx.x; asm volatile("" : "+v"(tid_));
    const int tid = tid_, wid = __builtin_amdgcn_readfirstlane(tid >> 6), lane = tid & 63, wr = wid >> 2, wc = wid & 3, fr = lane & 15, fq = lane >> 4;
    const int nt = K / BK;
    unsigned voffA[2], voffB[2];
#pragma unroll
    for (int i = 0; i < 2; ++i) { int R, C; stage_rc(tid * 16 + i * 8192, R, C); const int Rb = (R & ~31) + perm32(R & 31);
        voffA[i] = (unsigned)(R * lda + C) * 2u; voffB[i] = (unsigned)(Rb * ldb + C) * 2u; }
    const size_t kstep = (size_t)(BK * 2);
    const size_t hstepA = (size_t)HALF * lda * 2, hstepB = (size_t)HALF * ldb * 2;
    const unsigned ldsw = (unsigned)wid * 1024u;
    const int aoff = lds_byte(wr * 64 + fr, fq * 8), boff = lds_byte(wc * 32 + fr, fq * 8);
#define PG8_SA(b, h) (((b) * 2 + (h)) * HTB)
#define PG8_SB(b, h) ((4 + (b) * 2 + (h)) * HTB)
#define PG8_STAGE(bufoff, gbase, voff) do { _Pragma("unroll") for (int _i = 0; _i < 2; ++_i) \
        __builtin_amdgcn_global_load_lds((const unsigned*)((const char*)(gbase) + (voff)[_i]), (LAS unsigned*)(lds + (bufoff) + ldsw + _i * 8192), 16, 0, 0); } while (0)
#define PG8_LDA(dst, b, h) do { _Pragma("unroll") for (int m = 0; m < 4; ++m) _Pragma("unroll") for (int k = 0; k < 2; ++k) dst[m][k] = *(const LAS bf16x8*)(lds + PG8_SA(b, h) + aoff + m * 2048 + k * 1024); } while (0)
#define PG8_LDB(dst, b, h) do { _Pragma("unroll") for (int n = 0; n < 2; ++n) _Pragma("unroll") for (int k = 0; k < 2; ++k) dst[n][k] = *(const LAS bf16x8*)(lds + PG8_SB(b, h) + boff + n * 2048 + k * 1024); } while (0)
#define PG8_MMA(ai, bj, At, Bt) do { __builtin_amdgcn_s_setprio(1); _Pragma("unroll") for (int m = 0; m < 4; ++m) _Pragma("unroll") for (int n = 0; n < 2; ++n) _Pragma("unroll") for (int k = 0; k < 2; ++k) \
        acc[ai][bj][m][n] = __builtin_amdgcn_mfma_f32_16x16x32_bf16(Bt[n][k], At[m][k], acc[ai][bj][m][n], 0, 0, 0); __builtin_amdgcn_s_setprio(0); } while (0)
#define PG8_WAIT_V(n) asm volatile("s_waitcnt vmcnt(" #n ")" ::: "memory")
#define PG8_WAIT_L(n) asm volatile("s_waitcnt lgkmcnt(" #n ")" ::: "memory")
#define PG8_BAR __builtin_amdgcn_s_barrier()
#define PG8_SCHED __builtin_amdgcn_sched_barrier(0)
    GU cur, nxt; int ui = 0;
    if (!S.next(0, cur)) return;
    f32x4 acc[2][2][4][2];
#pragma unroll
    for (int a = 0; a < 2; ++a)
#pragma unroll
        for (int b = 0; b < 2; ++b)
#pragma unroll
            for (int m = 0; m < 4; ++m)
#pragma unroll
                for (int n = 0; n < 2; ++n) acc[a][b][m][n] = (f32x4){0.f, 0.f, 0.f, 0.f};
    bf16x8 At[4][2], B0[2][2], B1[2][2];
    const char* cA = cur.A; const char* cB = cur.B;
    PG8_STAGE(PG8_SB(0, 0), cB, voffB); PG8_STAGE(PG8_SB(0, 1), cB + hstepB, voffB); PG8_STAGE(PG8_SA(0, 0), cA, voffA); PG8_STAGE(PG8_SA(0, 1), cA + hstepA, voffA);
    if (wr == 1) PG8_BAR;
    PG8_WAIT_V(2); PG8_BAR;
    PG8_STAGE(PG8_SB(1, 0), cB + kstep, voffB); PG8_STAGE(PG8_SA(1, 0), cA + kstep, voffA); PG8_STAGE(PG8_SB(1, 1), cB + hstepB + kstep, voffB);
    PG8_WAIT_V(6); PG8_BAR;
    for (;;) {
        const bool has_next = S.next(ui + 1, nxt);
        const char* nA = has_next ? nxt.A : cA; const char* nB = has_next ? nxt.B : cB;
        for (int t = 0; t < nt; t += 2) {
            const bool last = (t == nt - 2);
            const char* a1 = cA + (size_t)(t + 1) * kstep;
            const char* a2 = last ? nA : cA + (size_t)(t + 2) * kstep; const char* b2 = last ? nB : cB + (size_t)(t + 2) * kstep;
            const char* a3 = a2 + kstep; const char* b3 = b2 + kstep;
            PG8_LDB(B0, 0, 0); PG8_LDB(B1, 0, 1); PG8_SCHED; PG8_LDA(At, 0, 0); PG8_STAGE(PG8_SA(1, 1), a1 + hstepA, voffA);
            PG8_WAIT_V(8); PG8_WAIT_L(0); PG8_BAR; PG8_MMA(0, 0, At, B0); PG8_MMA(0, 1, At, B1); PG8_BAR; PG8_SCHED;
            PG8_LDA(At, 0, 1); PG8_STAGE(PG8_SB(0, 0), b2, voffB); PG8_STAGE(PG8_SB(0, 1), b2 + hstepB, voffB); PG8_STAGE(PG8_SA(0, 0), a2, voffA);
            PG8_WAIT_V(8); PG8_WAIT_L(0); PG8_BAR; PG8_MMA(1, 0, At, B0); PG8_MMA(1, 1, At, B1); PG8_BAR; PG8_SCHED;
            PG8_LDB(B0, 1, 0); PG8_LDB(B1, 1, 1); PG8_SCHED; PG8_LDA(At, 1, 0); PG8_STAGE(PG8_SA(0, 1), a2 + hstepA, voffA);
            PG8_WAIT_V(8); PG8_WAIT_L(0); PG8_BAR; PG8_MMA(0, 0, At, B0); PG8_MMA(0, 1, At, B1); PG8_BAR; PG8_SCHED;
            PG8_LDA(At, 1, 1); PG8_STAGE(PG8_SB(1, 0), b3, voffB); PG8_STAGE(PG8_SB(1, 1), b3 + hstepB, voffB); PG8_STAGE(PG8_SA(1, 0), a3, voffA);
            PG8_WAIT_V(8); PG8_WAIT_L(0); PG8_BAR; PG8_MMA(1, 0, At, B0); PG8_MMA(1, 1, At, B1); PG8_BAR; PG8_SCHED;
        }
        if constexpr (ALIGN_EPI) { if (wr == 0) PG8_BAR; }
        E(acc, cur, wr, wc, fr, fq, lds);
        if (!has_next) break;
#pragma unroll
        for (int a = 0; a < 2; ++a)
#pragma unroll
            for (int b = 0; b < 2; ++b)
#pragma unroll
                for (int m = 0; m < 4; ++m)
#pragma unroll
                    for (int n = 0; n < 2; ++n) acc[a][b][m][n] = (f32x4){0.f, 0.f, 0.f, 0.f};
        cur = nxt; cA = nA; cB = nB; ++ui;
        if constexpr (ALIGN_EPI) { if (wr == 1) PG8_BAR; }
    }
    PG8_WAIT_V(0);
    if constexpr (!ALIGN_EPI) { if (wr == 0) PG8_BAR; }
    PG8_BAR;
#undef PG8_SA
#undef PG8_SB
#undef PG8_STAGE
#undef PG8_LDA
#undef PG8_LDB
#undef PG8_MMA
#undef PG8_WAIT_V
#undef PG8_WAIT_L
#undef PG8_BAR
#undef PG8_SCHED
}

template <int nM, int nN, int c0mul> struct MapReg {
    Order<nM, nN> o; const char* A; const char* B; size_t astep, bstep;
    __device__ __forceinline__ bool next(int i, GU& u) const { Tile t; if (!o.tile(i, t)) return false;
        u.A = A + (size_t)t.pm * astep; u.B = B + (size_t)t.pn * bstep; u.r0 = t.pm * BM; u.c0 = t.pn * c0mul; u.aux = t.pn; return true; }
};
struct MapPool {
    Order<M / BM, D / BM> o; const char* A; const char* B;
    __device__ __forceinline__ bool next(int i, GU& u) const { Tile t; if (!o.tile(i, t)) return false;
        u.A = A + ((size_t)t.pm * BM * D + (size_t)(t.pn >> 1) * 512) * 2; u.B = B + (size_t)t.pn * BM * 512 * 2; u.r0 = t.pm * BM; u.c0 = t.pn * BM; u.aux = t.pn; return true; }
};
struct MapS {
    Order<M / BM, NH> o; const char* Q; const char* Kl;
    __device__ __forceinline__ bool next(int i, GU& u) const { Tile t; if (!o.tile(i, t)) return false;
        u.A = Q + ((size_t)t.pm * BM * D + (size_t)t.pn * HD) * 2; u.B = Kl + ((size_t)(t.pm >> 3) * NMEM * (4 * D) + (size_t)t.pn * HD) * 2; u.r0 = t.pm * BM; u.c0 = t.pn * NMEM; u.aux = t.pn; return true; }
};
struct MapPV {
    Order<M / BM, D / BM> o; const char* P; const char* Vl;
    __device__ __forceinline__ bool next(int i, GU& u) const { Tile t; if (!o.tile(i, t)) return false;
        u.A = P + ((size_t)t.pm * BM * 1024 + (size_t)(t.pn >> 1) * NMEM) * 2; u.B = Vl + ((size_t)t.pn * BM * MM + (size_t)(t.pm >> 3) * NMEM) * 2; u.r0 = t.pm * BM; u.c0 = t.pn * BM; u.aux = t.pn >> 1; return true; }
};

template <bool SS, bool RS = false> struct EpiPlain {
    bf16_t* O; int ldc; float* ssp; const float* rinv;
    __device__ __forceinline__ void operator()(const f32x4 (&acc)[2][2][4][2], const GU& u, int wr, int wc, int fr, int fq, LAS unsigned char*) const {
        const int row0 = u.r0 + wr * 64 + fr, col0 = u.c0 + wc * 32 + 8 * fq;
#pragma unroll
        for (int ai = 0; ai < 2; ++ai)
#pragma unroll
            for (int m = 0; m < 4; ++m) { const int row = row0 + ai * HALF + m * 16; bf16_t* rowp = O + (size_t)row * ldc + col0; float s = 0.f;
                const float r = RS ? rinv[row] : 1.f;
#pragma unroll
                for (int bj = 0; bj < 2; ++bj) { f32x4 v0 = acc[ai][bj][m][0], v1 = acc[ai][bj][m][1];
                    if (RS) { v0 = v0 * r; v1 = v1 * r; }
                    if (SS) s += (v0[0] * v0[0] + v0[1] * v0[1]) + (v0[2] * v0[2] + v0[3] * v0[3]) + (v1[0] * v1[0] + v1[1] * v1[1]) + (v1[2] * v1[2] + v1[3] * v1[3]);
                    u32x4 w; w.x = cvt_pk_bf16(v0[0], v0[1]); w.y = cvt_pk_bf16(v0[2], v0[3]); w.z = cvt_pk_bf16(v1[0], v1[1]); w.w = cvt_pk_bf16(v1[2], v1[3]);
                    *(u32x4*)(rowp + bj * HALF) = w; }
                if (SS) { s += __shfl_xor(s, 16); s += __shfl_xor(s, 32); if (fq == 0) ssp[(size_t)row * 32 + (u.c0 >> 8) * 4 + wc] = s; } }
    }
};
struct EpiGeluUV {
    bf16_t* U; bf16_t* V; float* vst; const float* rinv;
    __device__ __forceinline__ void operator()(const f32x4 (&acc)[2][2][4][2], const GU& u, int wr, int wc, int fr, int fq, LAS unsigned char*) const {
        const bool isv = u.c0 >= DG; const int cbase = isv ? u.c0 - DG : u.c0; bf16_t* O = isv ? V : U;
        const int row0 = u.r0 + wr * 64 + fr, col0 = cbase + wc * 32 + 8 * fq;
#pragma unroll
        for (int ai = 0; ai < 2; ++ai)
#pragma unroll
            for (int m = 0; m < 4; ++m) { const int row = row0 + ai * HALF + m * 16; bf16_t* rowp = O + (size_t)row * DG + col0; float s = 0.f, q = 0.f;
                const float r = rinv[row];
#pragma unroll
                for (int bj = 0; bj < 2; ++bj) { f32x4 v0 = acc[ai][bj][m][0], v1 = acc[ai][bj][m][1];
#pragma unroll
                    for (int e = 0; e < 4; ++e) { v0[e] = gelu_tanh_f(v0[e] * r); v1[e] = gelu_tanh_f(v1[e] * r); }
                    s += (v0[0] + v0[1]) + (v0[2] + v0[3]) + (v1[0] + v1[1]) + (v1[2] + v1[3]);
                    q += (v0[0] * v0[0] + v0[1] * v0[1]) + (v0[2] * v0[2] + v0[3] * v0[3]) + (v1[0] * v1[0] + v1[1] * v1[1]) + (v1[2] * v1[2] + v1[3] * v1[3]);
                    u32x4 w; w.x = cvt_pk_bf16(v0[0], v0[1]); w.y = cvt_pk_bf16(v0[2], v0[3]); w.z = cvt_pk_bf16(v1[0], v1[1]); w.w = cvt_pk_bf16(v1[2], v1[3]);
                    *(u32x4*)(rowp + bj * HALF) = w; }
                if (isv) { s += __shfl_xor(s, 16); s += __shfl_xor(s, 32); q += __shfl_xor(q, 16); q += __shfl_xor(q, 32);
                    if (fq == 0) *(f32x2*)(vst + ((size_t)row * 32 + (cbase >> 8) * 4 + wc) * 2) = (f32x2){s, q}; } }
    }
};
struct EpiSwiglu {
    bf16_t* HF; const float* rinv;
    __device__ __forceinline__ void operator()(const f32x4 (&acc)[2][2][4][2], const GU& u, int wr, int wc, int fr, int fq, LAS unsigned char*) const {
        const int row0 = u.r0 + wr * 64 + fr, col0 = u.c0 + wc * 32 + 8 * fq;
#pragma unroll
        for (int ai = 0; ai < 2; ++ai)
#pragma unroll
            for (int m = 0; m < 4; ++m) { const int row = row0 + ai * HALF + m * 16; float o[8]; const float r = rinv[row];
#pragma unroll
                for (int n = 0; n < 2; ++n)
#pragma unroll
                    for (int e = 0; e < 4; ++e) o[n * 4 + e] = silu_f(acc[ai][0][m][n][e] * r) * (acc[ai][1][m][n][e] * r);
                u32x4 w; w.x = cvt_pk_bf16(o[0], o[1]); w.y = cvt_pk_bf16(o[2], o[3]); w.z = cvt_pk_bf16(o[4], o[5]); w.w = cvt_pk_bf16(o[6], o[7]);
                *(u32x4*)(HF + (size_t)row * DFF + col0) = w; }
    }
};
struct EpiSoftmax {
    bf16_t* PT; float* rsp;
    __device__ __forceinline__ void operator()(const f32x4 (&acc)[2][2][4][2], const GU& u, int wr, int wc, int fr, int fq, LAS unsigned char* lds) const {
        LAS float* red = (LAS float*)(lds + RED_OFF);
#pragma unroll
        for (int ai = 0; ai < 2; ++ai)
#pragma unroll
            for (int m = 0; m < 4; ++m) { float mx = -3.0e38f;
#pragma unroll
                for (int bj = 0; bj < 2; ++bj)
#pragma unroll
                    for (int n = 0; n < 2; ++n)
#pragma unroll
                        for (int e = 0; e < 4; ++e) mx = fmaxf(mx, acc[ai][bj][m][n][e]);
                mx = fmaxf(mx, __shfl_xor(mx, 16)); mx = fmaxf(mx, __shfl_xor(mx, 32));
                if (fq == 0) red[(ai * HALF + wr * 64 + m * 16 + fr) * 4 + wc] = mx; }
        asm volatile("s_waitcnt lgkmcnt(0)" ::: "memory"); __builtin_amdgcn_s_barrier(); asm volatile("" ::: "memory");
        const int row0 = u.r0 + wr * 64 + fr, col0 = u.c0 + wc * 32 + 8 * fq;
#pragma unroll
        for (int ai = 0; ai < 2; ++ai)
#pragma unroll
            for (int m = 0; m < 4; ++m) { const int rl = ai * HALF + wr * 64 + m * 16 + fr; const int row = row0 + ai * HALF + m * 16;
                const f32x4 r4 = *(const LAS f32x4*)(red + rl * 4); const float mx = fmaxf(fmaxf(r4[0], r4[1]), fmaxf(r4[2], r4[3])) * 1.4426950408889634f;
                float s = 0.f; bf16_t* rowp = PT + (size_t)row * 1024 + col0;
#pragma unroll
                for (int bj = 0; bj < 2; ++bj) { f32x4 v0 = acc[ai][bj][m][0], v1 = acc[ai][bj][m][1];
#pragma unroll
                    for (int e = 0; e < 4; ++e) { v0[e] = __builtin_amdgcn_exp2f(v0[e] * 1.4426950408889634f - mx); v1[e] = __builtin_amdgcn_exp2f(v1[e] * 1.4426950408889634f - mx); }
                    s += (v0[0] + v0[1]) + (v0[2] + v0[3]) + (v1[0] + v1[1]) + (v1[2] + v1[3]);
                    u32x4 w; w.x = cvt_pk_bf16(v0[0], v0[1]); w.y = cvt_pk_bf16(v0[2], v0[3]); w.z = cvt_pk_bf16(v1[0], v1[1]); w.w = cvt_pk_bf16(v1[2], v1[3]);
                    *(u32x4*)(rowp + bj * HALF) = w; }
                s += __shfl_xor(s, 16); s += __shfl_xor(s, 32);
                if (fq == 0) rsp[(size_t)row * 16 + u.aux * 4 + wc] = s; }
    }
};
struct EpiPV {
    bf16_t* OB; const float* rsp;
    __device__ __forceinline__ void operator()(const f32x4 (&acc)[2][2][4][2], const GU& u, int wr, int wc, int fr, int fq, LAS unsigned char*) const {
        const int row0 = u.r0 + wr * 64 + fr, col0 = u.c0 + wc * 32 + 8 * fq;
#pragma unroll
        for (int ai = 0; ai < 2; ++ai)
#pragma unroll
            for (int m = 0; m < 4; ++m) { const int row = row0 + ai * HALF + m * 16; bf16_t* rowp = OB + (size_t)row * D + col0;
                const f32x4 r4 = *(const f32x4*)(rsp + (size_t)row * 16 + u.aux * 4); const float inv = 1.f / ((r4[0] + r4[1]) + (r4[2] + r4[3]));
#pragma unroll
                for (int bj = 0; bj < 2; ++bj) { const f32x4 v0 = acc[ai][bj][m][0] * inv, v1 = acc[ai][bj][m][1] * inv;
                    u32x4 w; w.x = cvt_pk_bf16(v0[0], v0[1]); w.y = cvt_pk_bf16(v0[2], v0[3]); w.z = cvt_pk_bf16(v1[0], v1[1]); w.w = cvt_pk_bf16(v1[2], v1[3]);
                    *(u32x4*)(rowp + bj * HALF) = w; } }
    }
};

struct Args { const float* in[21]; float* out; unsigned char* ws; };
struct Frame { LAS unsigned char* lds; int tid, lane, wave, vcu; static constexpr int G = GRID; };
__device__ __forceinline__ Frame make_frame(LAS unsigned char* lds) {
    Frame F; F.lds = lds; int t_ = threadIdx.x; asm volatile("" : "+v"(t_)); F.tid = t_; F.lane = F.tid & 63; F.wave = __builtin_amdgcn_readfirstlane(F.tid >> 6);
    int bx = blockIdx.x; asm volatile("" : "+s"(bx)); F.vcu = (bx % 8) * (GRID / 8) + bx / 8; return F; }

__device__ __forceinline__ void tr_item(const float* W, int ldw, int K, const float* kg, const float* ng, float cmul, bf16_t* WT, int blk, int blkstride, int blkoff,
                                        LAS float* scr, int item, int nblk, int lane) {
    const int kb = item / nblk, nb = item % nblk, k0 = 64 * kb, n0 = 32 * nb;
    const float gn = (ng ? ng[n0 + (lane & 31)] : 1.f) * cmul;
#pragma unroll 8
    for (int i = 0; i < 32; ++i) { const int kk = 2 * i + (lane >> 5); const float gk = kg ? kg[k0 + kk] : 1.f;
        scr[kk * 33 + (lane & 31)] = W[(size_t)(k0 + kk) * ldw + n0 + (lane & 31)] * (gk * gn); }
    LDS_WAIT(); asm volatile("" ::: "memory");
    const int c = lane & 7;
    const int rbase = (n0 / blk) * blkstride + blkoff + (n0 % blk);
#pragma unroll
    for (int j = 0; j < 4; ++j) { const int n = (lane >> 3) + 8 * j; const LAS float* s = scr + (8 * c) * 33 + n;
        u32x4 o; o.x = cvt_pk_bf16(s[0 * 33], s[1 * 33]); o.y = cvt_pk_bf16(s[2 * 33], s[3 * 33]); o.z = cvt_pk_bf16(s[4 * 33], s[5 * 33]); o.w = cvt_pk_bf16(s[6 * 33], s[7 * 33]);
        *(u32x4*)(WT + (size_t)(rbase + n) * K + k0 + 8 * c) = o; }
    LDS_WAIT(); asm volatile("" ::: "memory");
}
__device__ __forceinline__ void tr_job(const Frame& F, int& base, const float* W, int ldw, int K, int N, const float* kg, const float* ng, float cmul, bf16_t* WT, int blk, int blkstride, int blkoff) {
    const int NGW = GRID * NWAVES, gw = F.vcu * NWAVES + F.wave;
    LAS float* scr = (LAS float*)(F.lds + F.wave * 16384);
    const int nblk = N / 32, nitems = (K / 64) * nblk;
    int first = (gw - (base % NGW) + NGW) % NGW;
    for (int it = first; it < nitems; it += NGW) tr_item(W, ldw, K, kg, ng, cmul, WT, blk, blkstride, blkoff, scr, it, nblk, F.lane);
    base += nitems;
}

template <bool NORM>
__device__ __forceinline__ void row_to_bf16(const float* src, bf16_t* dstb, float* rinv_out, int lane) {
    f32x4 v[8]; float ss = 0.f;
#pragma unroll
    for (int j = 0; j < 4; ++j) { const f32x4* p = (const f32x4*)(src + j * 512 + lane * 8); v[2 * j] = p[0]; v[2 * j + 1] = p[1]; }
#pragma unroll
    for (int j = 0; j < 8; ++j) ss += (v[j][0] * v[j][0] + v[j][1] * v[j][1]) + (v[j][2] * v[j][2] + v[j][3] * v[j][3]);
    const float rinv = rsqrtf(wave_sum(ss) * (1.f / D) + EPS); const float sc = NORM ? rinv : 1.f;
    if (!NORM && lane == 0) *rinv_out = rinv;
#pragma unroll
    for (int j = 0; j < 4; ++j) {
        const f32x4 a = v[2 * j] * sc, b = v[2 * j + 1] * sc;
        u32x4 w; w.x = cvt_pk_bf16(a[0], a[1]); w.y = cvt_pk_bf16(a[2], a[3]); w.z = cvt_pk_bf16(b[0], b[1]); w.w = cvt_pk_bf16(b[2], b[3]);
        *(u32x4*)(dstb + j * 512 + lane * 8) = w; }
}

template <bool FINAL>
__device__ __forceinline__ void row_pass(const Frame& F, bf16_t* XBp, const bf16_t* HB, const float* ssp, const float* g, float* rinv_out, float* OUT) {
    const int NGW = GRID * NWAVES, gw = F.vcu * NWAVES + F.wave, lane = F.lane;
    f32x4 gv[8];
#pragma unroll
    for (int j = 0; j < 4; ++j) { const f32x4* p = (const f32x4*)(g + j * 512 + lane * 8); gv[2 * j] = p[0]; gv[2 * j + 1] = p[1]; }
    for (int row = gw; row < M; row += NGW) {
        bf16_t* xr = XBp + (size_t)row * D; const bf16_t* hr = HB + (size_t)row * D;
        u32x4 xw[4], hw[4];
#pragma unroll
        for (int j = 0; j < 4; ++j) { xw[j] = *(const u32x4*)(xr + j * 512 + lane * 8); hw[j] = *(const u32x4*)(hr + j * 512 + lane * 8); }
        const float part = lane < 32 ? ssp[(size_t)row * 32 + lane] : 0.f;
        const float rh = rsqrtf(wave_sum(part) * (1.f / D) + EPS);
        float ss = 0.f;
#pragma unroll
        for (int j = 0; j < 4; ++j) {
            const f32x4 x0 = (f32x4){bf_lo(xw[j].x), bf_hi(xw[j].x), bf_lo(xw[j].y), bf_hi(xw[j].y)}, x1 = (f32x4){bf_lo(xw[j].z), bf_hi(xw[j].z), bf_lo(xw[j].w), bf_hi(xw[j].w)};
            const f32x4 h0 = (f32x4){bf_lo(hw[j].x), bf_hi(hw[j].x), bf_lo(hw[j].y), bf_hi(hw[j].y)}, h1 = (f32x4){bf_lo(hw[j].z), bf_hi(hw[j].z), bf_lo(hw[j].w), bf_hi(hw[j].w)};
            const f32x4 a = x0 + h0 * rh * gv[2 * j], b = x1 + h1 * rh * gv[2 * j + 1];
            if (FINAL) { f32x4* p = (f32x4*)(OUT + (size_t)row * D + j * 512 + lane * 8); p[0] = a; p[1] = b; }
            else { ss += (a[0] * a[0] + a[1] * a[1]) + (a[2] * a[2] + a[3] * a[3]) + (b[0] * b[0] + b[1] * b[1]) + (b[2] * b[2] + b[3] * b[3]);
                u32x4 w; w.x = cvt_pk_bf16(a[0], a[1]); w.y = cvt_pk_bf16(a[2], a[3]); w.z = cvt_pk_bf16(b[0], b[1]); w.w = cvt_pk_bf16(b[2], b[3]);
                *(u32x4*)(xr + j * 512 + lane * 8) = w; } }
        if (!FINAL) { const float rinv = rsqrtf(wave_sum(ss) * (1.f / D) + EPS); if (lane == 0) rinv_out[row] = rinv; }
    }
}

__device__ __forceinline__ void ld8(const bf16_t* p, float (&o)[8]) { const u32x4 w = *(const u32x4*)p; o[0] = bf_lo(w.x); o[1] = bf_hi(w.x); o[2] = bf_lo(w.y); o[3] = bf_hi(w.y); o[4] = bf_lo(w.z); o[5] = bf_hi(w.z); o[6] = bf_lo(w.w); o[7] = bf_hi(w.w); }
__device__ __forceinline__ void ld8s(const bf16_t* p, float sc, float (&o)[8]) { ld8(p, o);
#pragma unroll
    for (int e = 0; e < 8; ++e) o[e] *= sc; }
__device__ __forceinline__ void pool_pre(const Frame& F, const bf16_t* XBp, const float* rinv, bf16_t* DA) {
    const int gt = F.vcu * NTHREADS + F.tid, NT = GRID * NTHREADS;
    for (int it = gt; it < (M / 16) * (D / 8); it += NT) {
        const int cc = it % (D / 8), rb = it / (D / 8); const int half = 1 << (cc >> 6);
        const int r0 = rb * 16, t0 = r0 % SEQ; const bf16_t* base = XBp + (size_t)(r0 - t0) * D + cc * 8;
        const float* rb0 = rinv + (r0 - t0);
        float s[8];
#pragma unroll
        for (int e = 0; e < 8; ++e) s[e] = 0.f;
        for (int tt = t0 - half; tt < t0 + half - 1; ++tt) if (tt >= 0 && tt < SEQ) { float v[8]; ld8s(base + (size_t)tt * D, rb0[tt], v);
#pragma unroll
            for (int e = 0; e < 8; ++e) s[e] += v[e]; }
        for (int t = t0; t < t0 + 16; ++t) {
            const int ta = t + half - 1;
            if (ta < SEQ) { float v[8]; ld8s(base + (size_t)ta * D, rb0[ta], v);
#pragma unroll
                for (int e = 0; e < 8; ++e) s[e] += v[e]; }
            const int lo = t - half > 0 ? t - half : 0, hi = t + half < SEQ ? t + half : SEQ; const float ic = 1.f / (float)(hi - lo);
            float c[8], o[8]; ld8s(base + (size_t)t * D, rb0[t], c);
#pragma unroll
            for (int e = 0; e < 8; ++e) o[e] = s[e] * ic - c[e];
            u32x4 w; w.x = cvt_pk_bf16(o[0], o[1]); w.y = cvt_pk_bf16(o[2], o[3]); w.z = cvt_pk_bf16(o[4], o[5]); w.w = cvt_pk_bf16(o[6], o[7]);
            *(u32x4*)(DA + (size_t)(r0 - t0 + t) * D + cc * 8) = w;
            const int ts = t - half;
            if (ts >= 0) { float v[8]; ld8s(base + (size_t)ts * D, rb0[ts], v);
#pragma unroll
                for (int e = 0; e < 8; ++e) s[e] -= v[e]; }
        }
    }
}

__device__ __forceinline__ int tswz(int c) { return ((c & 3) ^ ((((c >> 3) ^ (c >> 7)) & 1) | (((c >> 6) & 1) << 1))) | (((c >> 4) & 3) << 2); }
__device__ __forceinline__ void spatial_phase(const Frame& F, const bf16_t* U, const bf16_t* V, const float* vst, const bf16_t* Wsb, const float* bs, const float* lng, const float* lnb, bf16_t* GATED) {
    LAS unsigned char* T = F.lds; LAS f32x2* st = (LAS f32x2*)(F.lds + 65536);
    const int tid = F.tid, lane = F.lane, w = F.wave;
    for (int idx = F.vcu; idx < (M / 128) * 8; idx += GRID) {
        const int chunk = idx >> 3, head = idx & 7; const size_t rowb = (size_t)chunk * 128;
        __syncthreads();
        if (tid < 128) { const f32x4* p = (const f32x4*)(vst + (rowb + tid) * 64); float s = 0.f, q = 0.f;
#pragma unroll
            for (int i = 0; i < 16; ++i) { const f32x4 x = p[i]; s += x[0] + x[2]; q += x[1] + x[3]; }
            const float mu = s * (1.f / DG); const float var = q * (1.f / DG) - mu * mu; st[tid] = (f32x2){mu, rsqrtf(fmaxf(var, 0.f) + EPS)}; }
        __syncthreads();
        {
            const int c8 = (tid & 31) * 8, qg = tid >> 5; float lg[8], lb[8];
#pragma unroll
            for (int e = 0; e < 8; ++e) { lg[e] = lng[head * 256 + c8 + e]; lb[e] = lnb[head * 256 + c8 + e]; }
            float x[8][8];
#pragma unroll
            for (int r = 0; r < 8; ++r) { const int q = qg * 8 + r; float v[8]; ld8(V + (rowb + q) * DG + head * 256 + c8, v); const f32x2 ms = st[q];
#pragma unroll
                for (int e = 0; e < 8; ++e) x[r][e] = (v[e] - ms.x) * ms.y * lg[e] + lb[e]; }
#pragma unroll
            for (int e = 0; e < 8; ++e) { const int c = c8 + e; u32x4 wv; wv.x = cvt_pk_bf16(x[0][e], x[1][e]); wv.y = cvt_pk_bf16(x[2][e], x[3][e]); wv.z = cvt_pk_bf16(x[4][e], x[5][e]); wv.w = cvt_pk_bf16(x[6][e], x[7][e]);
                *(LAS u32x4*)(T + c * 256 + ((qg ^ tswz(c)) << 4)) = wv; }
        }
        bf16x8 wf[4];
#pragma unroll
        for (int ks = 0; ks < 4; ++ks) wf[ks] = *(const bf16x8*)(Wsb + ((size_t)head * 128 + 16 * w + (lane & 15)) * 128 + ks * 32 + (lane >> 4) * 8);
        __syncthreads();
        f32x4 acc[16];
#pragma unroll
        for (int nb = 0; nb < 16; ++nb) acc[nb] = (f32x4){0.f, 0.f, 0.f, 0.f};
        const int s = lane & 15, kq = lane >> 4;
#pragma unroll
        for (int nb = 0; nb < 16; ++nb) { const int c = 64 * (nb >> 2) + 16 * (s >> 2) + 4 * (nb & 3) + (s & 3); const int sw = tswz(c);
#pragma unroll
            for (int ks = 0; ks < 4; ++ks) { const bf16x8 tf = *(const LAS bf16x8*)(T + c * 256 + (((ks * 4 + kq) ^ sw) << 4));
                acc[nb] = __builtin_amdgcn_mfma_f32_16x16x32_bf16(tf, wf[ks], acc[nb], 0, 0, 0); } }
        const int p = 16 * w + (lane & 15), g4 = lane >> 4; const float bias = bs[head * 128 + p];
        const size_t orow = (rowb + p) * DG + head * 256;
#pragma unroll
        for (int a = 0; a < 4; ++a) { float ua[8], ub[8]; ld8(U + orow + 64 * a + 16 * g4, ua); ld8(U + orow + 64 * a + 16 * g4 + 8, ub);
            float o[16];
#pragma unroll
            for (int b = 0; b < 2; ++b)
#pragma unroll
                for (int e = 0; e < 4; ++e) { o[4 * b + e] = ua[4 * b + e] * (acc[4 * a + b][e] + bias); o[8 + 4 * b + e] = ub[4 * b + e] * (acc[4 * a + 2 + b][e] + bias); }
            u32x4 w0, w1; w0.x = cvt_pk_bf16(o[0], o[1]); w0.y = cvt_pk_bf16(o[2], o[3]); w0.z = cvt_pk_bf16(o[4], o[5]); w0.w = cvt_pk_bf16(o[6], o[7]);
            w1.x = cvt_pk_bf16(o[8], o[9]); w1.y = cvt_pk_bf16(o[10], o[11]); w1.z = cvt_pk_bf16(o[12], o[13]); w1.w = cvt_pk_bf16(o[14], o[15]);
            *(u32x4*)(GATED + orow + 64 * a + 16 * g4) = w0; *(u32x4*)(GATED + orow + 64 * a + 16 * g4 + 8) = w1; }
    }
    __syncthreads();
}

__device__ __forceinline__ const __attribute__((address_space(4))) Args* kargs() {
    const __attribute__((address_space(4))) Args* p = (const __attribute__((address_space(4))) Args*)__builtin_amdgcn_kernarg_segment_ptr();
    asm volatile("" : "+s"(p));
    return p;
}
#define KIN(k) (kargs()->in[k])
#define WSP(off) (kargs()->ws + (off))
#define x_prompt KIN(0)
#define x_sample KIN(1)
#define mem_prompt KIN(2)
#define mem_sample KIN(3)
#define norm_gains KIN(4)
#define mem_norm KIN(5)
#define pool_w KIN(6)
#define pool_scale KIN(7)
#define gmlp_w_in KIN(8)
#define gmlp_ln_g KIN(9)
#define gmlp_ln_b KIN(10)
#define gmlp_w_s KIN(11)
#define gmlp_b_s KIN(12)
#define gmlp_w_out KIN(13)
#define attn_wq KIN(14)
#define attn_wk KIN(15)
#define attn_wv KIN(16)
#define attn_wo KIN(17)
#define ffn_w_gate KIN(18)
#define ffn_w_up KIN(19)
#define ffn_w_down KIN(20)
#define X (kargs()->out)
#define WPOOL ((bf16_t*)WSP(WS_WPOOL))
#define WSB ((bf16_t*)WSP(WS_WS))
#define WIN ((bf16_t*)WSP(WS_WIN))
#define WOUT ((bf16_t*)WSP(WS_WOUT))
#define WQ ((bf16_t*)WSP(WS_WQ))
#define WK ((bf16_t*)WSP(WS_WK))
#define WV ((bf16_t*)WSP(WS_WV))
#define WO ((bf16_t*)WSP(WS_WO))
#define WGU ((bf16_t*)WSP(WS_WGU))
#define WDN ((bf16_t*)WSP(WS_WDN))
#define MEMBN ((bf16_t*)WSP(WS_MEMBN))
#define KMAT ((bf16_t*)WSP(WS_KMAT))
#define VT ((bf16_t*)WSP(WS_VT))
#define XB ((bf16_t*)WSP(WS_XB))
#define HB ((bf16_t*)WSP(WS_HB))
#define SSP ((float*)WSP(WS_SSP))
#define VST ((float*)WSP(WS_VST))
#define RSP ((float*)WSP(WS_RSP))
#define RINV ((float*)WSP(WS_RINV))
#define UB ((bf16_t*)WSP(WS_BIG + BIG_U))
#define VB ((bf16_t*)WSP(WS_BIG + BIG_V))
#define DA ((bf16_t*)WSP(WS_BIG + BIG_DA))
#define QB ((bf16_t*)WSP(WS_BIG + BIG_Q))
#define OB ((bf16_t*)WSP(WS_BIG + BIG_O))
#define PT ((bf16_t*)WSP(WS_BIG + BIG_PT))
#define HF ((bf16_t*)WSP(WS_BIG + BIG_HF))
#define GATED UB

#define GRID_BAR() do { XcdBarrier _b; _b.bar = (unsigned*)WSP(WS_CTL) + CW_BAR; _b.x = xb_xcc_id(); _b.st = (volatile LAS unsigned*)(lds + MISC_OFF) + 8; xcd_barrier(_b); if (BARX2) xcd_barrier(_b); } while (0)
#define MK_STEP (size_t)BM * D * 2
__global__ void __launch_bounds__(NTHREADS, 2) mega_fwd(Args args) {
    extern __shared__ __attribute__((aligned(16))) unsigned char lds_raw[];
    LAS unsigned char* const lds = (LAS unsigned char*)lds_raw; (void)args;
    if (gridDim.x != GRID) return;
    { volatile LAS unsigned* MISC = (volatile LAS unsigned*)(lds + MISC_OFF); if (threadIdx.x < 32) MISC[threadIdx.x] = 0u; __syncthreads();
      (void)xcd_barrier_post((unsigned*)WSP(WS_CTL) + CW_BAR, MISC + 8); }

    {
        const Frame F = make_frame(lds); const int NGW = GRID * NWAVES, gw = F.vcu * NWAVES + F.wave;
        int base = 0;
        if (PH(0)) REP(0) for (int i = 0; i < DEPTH; ++i) {
            const float* g = norm_gains + (size_t)i * 6 * D;
            tr_job(F, base, attn_wq + (size_t)i * D * D, D, D, D, g + 2 * D, nullptr, 0.04419417382415922f, WQ + (size_t)i * D * D, D, D, 0);
            tr_job(F, base, attn_wk + (size_t)i * D * D, D, D, D, mem_norm + (size_t)i * D, nullptr, 1.f, WK + (size_t)i * D * D, D, D, 0);
            tr_job(F, base, attn_wv + (size_t)i * D * D, D, D, D, mem_norm + (size_t)i * D, nullptr, 1.f, WV + (size_t)i * D * D, D, D, 0);
            tr_job(F, base, attn_wo + (size_t)i * D * D, D, D, D, nullptr, nullptr, 1.f, WO + (size_t)i * D * D, D, D, 0);
            tr_job(F, base, ffn_w_gate + (size_t)i * D * DFF, DFF, D, DFF, g + 4 * D, nullptr, 1.f, WGU + (size_t)i * 2 * DFF * D, 128, 256, 0);
            tr_job(F, base, ffn_w_up + (size_t)i * D * DFF, DFF, D, DFF, g + 4 * D, nullptr, 1.f, WGU + (size_t)i * 2 * DFF * D, 128, 256, 128);
            tr_job(F, base, ffn_w_down + (size_t)i * DFF * D, D, DFF, D, nullptr, nullptr, 1.f, WDN + (size_t)i * D * DFF, D, D, 0);
        }
        if (PH(0)) REP(0) for (int j = 0; j < 2; ++j) {
            const float* g0p = norm_gains + (size_t)(2 * j) * 6 * D;
            const float* g0g = norm_gains + (size_t)(2 * j + 1) * 6 * D;
            for (int gq = 0; gq < 4; ++gq)
                tr_job(F, base, pool_w + ((size_t)j * 4 + gq) * 512 * 512, 512, 512, 512, g0p + gq * 512, pool_scale + (size_t)j * D + gq * 512, 1.f, WPOOL + ((size_t)j * 4 + gq) * 512 * 512, 512, 512, 0);
            tr_job(F, base, gmlp_w_in + (size_t)j * D * 2 * DG, 2 * DG, D, 2 * DG, g0g, nullptr, 1.f, WIN + (size_t)j * 2 * DG * D, 2 * DG, 2 * DG, 0);
            tr_job(F, base, gmlp_w_out + (size_t)j * DG * D, D, DG, D, nullptr, nullptr, 1.f, WOUT + (size_t)j * D * DG, D, D, 0);
        }
        if (PH(1)) REP(1) for (int i = (F.vcu * NTHREADS + F.tid) * 8; i < 2 * 8 * 128 * 128; i += GRID * NTHREADS * 8) { const f32x4 a = *(const f32x4*)(gmlp_w_s + i), b = *(const f32x4*)(gmlp_w_s + i + 4);
            u32x4 w; w.x = cvt_pk_bf16(a[0], a[1]); w.y = cvt_pk_bf16(a[2], a[3]); w.z = cvt_pk_bf16(b[0], b[1]); w.w = cvt_pk_bf16(b[2], b[3]); *(u32x4*)(WSB + i) = w; }
        if (PH(1)) REP(1) for (int r = gw; r < MM; r += NGW) { const float* src = r < NPROMPT_MEM ? mem_prompt + (size_t)r * D : mem_sample + (size_t)(r - NPROMPT_MEM) * D; row_to_bf16<true>(src, MEMBN + (size_t)r * D, nullptr, F.lane); }
        if (PH(1)) REP(1) for (int r = gw; r < M; r += NGW) { const float* src = r < NPROMPT_ROWS ? x_prompt + (size_t)r * D : x_sample + (size_t)(r - NPROMPT_ROWS) * D; row_to_bf16<false>(src, XB + (size_t)r * D, RINV + r, F.lane); }
    }
    GRID_BAR();
    if (PH(2)) REP(2) {
        MapReg<MM / BM, (4 * D) / BM, BM> mp; mp.A = (const char*)MEMBN; mp.B = (const char*)WK; mp.astep = MK_STEP; mp.bstep = MK_STEP;
        EpiPlain<false> E{KMAT, 4 * D, nullptr, nullptr};
        gemm_phase<EpiPlain<false>, MapReg<MM / BM, (4 * D) / BM, BM>, MK_ALIGN>(lds, mp, E, D, D, D);
    }
    if (PH(2)) REP(2) {
        MapReg<(4 * D) / BM, MM / BM, BM> mp; mp.A = (const char*)WV; mp.B = (const char*)MEMBN; mp.astep = MK_STEP; mp.bstep = MK_STEP;
        EpiPlain<false> E{VT, MM, nullptr, nullptr};
        gemm_phase<EpiPlain<false>, MapReg<(4 * D) / BM, MM / BM, BM>, MK_ALIGN>(lds, mp, E, D, D, D);
    }
    GRID_BAR();

    for (int layer = 0; layer < DEPTH; ++layer) {
        if ((layer & 1) == 0) {
            if (PH(3)) REP(3) pool_pre(make_frame(lds), XB, RINV, DA);
            GRID_BAR();
            if (PH(4)) REP(4) {   MapPool mp; mp.A = (const char*)DA; mp.B = (const char*)(WPOOL + (size_t)(layer >> 1) * 4 * 512 * 512);
                EpiPlain<true> E{HB, D, SSP, nullptr};
                gemm_phase<EpiPlain<true>, MapPool, MK_ALIGN>(lds, mp, E, 512, D, 512); }
            GRID_BAR();
        } else {
            if (PH(5)) REP(5) {   MapReg<M / BM, (2 * DG) / BM, BM> mp; mp.A = (const char*)XB; mp.B = (const char*)(WIN + (size_t)(layer >> 1) * 2 * DG * D); mp.astep = MK_STEP; mp.bstep = MK_STEP;
                EpiGeluUV E{UB, VB, VST, RINV};
                gemm_phase<EpiGeluUV, MapReg<M / BM, (2 * DG) / BM, BM>, MK_ALIGN>(lds, mp, E, D, D, D); }
            GRID_BAR();
            if (PH(6)) REP(6) { const int j = layer >> 1; spatial_phase(make_frame(lds), UB, VB, VST, WSB + (size_t)j * 8 * 128 * 128, gmlp_b_s + (size_t)j * 8 * 128, gmlp_ln_g + (size_t)j * DG, gmlp_ln_b + (size_t)j * DG, GATED); }
            GRID_BAR();
            if (PH(7)) REP(7) {   MapReg<M / BM, D / BM, BM> mp; mp.A = (const char*)GATED; mp.B = (const char*)(WOUT + (size_t)(layer >> 1) * D * DG); mp.astep = MK_STEP; mp.bstep = MK_STEP;
                EpiPlain<true> E{HB, D, SSP, nullptr};
                gemm_phase<EpiPlain<true>, MapReg<M / BM, D / BM, BM>, MK_ALIGN>(lds, mp, E, DG, DG, DG); }
            GRID_BAR();
        }
        if (PH(8)) row_pass<false>(make_frame(lds), XB, HB, SSP, norm_gains + ((size_t)layer * 6 + 1) * D, RINV, nullptr);
        GRID_BAR();
        if (PH(9)) REP(9) {   MapReg<M / BM, D / BM, BM> mp; mp.A = (const char*)XB; mp.B = (const char*)(WQ + (size_t)layer * D * D); mp.astep = MK_STEP; mp.bstep = MK_STEP;
            EpiPlain<false, true> E{QB, D, nullptr, RINV};
            gemm_phase<EpiPlain<false, true>, MapReg<M / BM, D / BM, BM>, MK_ALIGN>(lds, mp, E, D, D, D); }
        GRID_BAR();
        if (PH(10)) REP(10) {   MapS mp; mp.Q = (const char*)QB; mp.Kl = (const char*)(KMAT + (size_t)layer * D);
            EpiSoftmax E{PT, RSP};
            gemm_phase<EpiSoftmax, MapS, true>(lds, mp, E, HD, D, 4 * D); }
        GRID_BAR();
        if (PH(11)) REP(11) {   MapPV mp; mp.P = (const char*)PT; mp.Vl = (const char*)(VT + (size_t)layer * D * MM);
            EpiPV E{OB, RSP};
            gemm_phase<EpiPV, MapPV, MK_ALIGN>(lds, mp, E, NMEM, 1024, MM); }
        GRID_BAR();
        if (PH(12)) REP(12) {   MapReg<M / BM, D / BM, BM> mp; mp.A = (const char*)OB; mp.B = (const char*)(WO + (size_t)layer * D * D); mp.astep = MK_STEP; mp.bstep = MK_STEP;
            EpiPlain<true> E{HB, D, SSP, nullptr};
            gemm_phase<EpiPlain<true>, MapReg<M / BM, D / BM, BM>, MK_ALIGN>(lds, mp, E, D, D, D); }
        GRID_BAR();
        if (PH(8)) row_pass<false>(make_frame(lds), XB, HB, SSP, norm_gains + ((size_t)layer * 6 + 3) * D, RINV, nullptr);
        GRID_BAR();
        if (PH(13)) REP(13) {   MapReg<M / BM, (2 * DFF) / BM, 128> mp; mp.A = (const char*)XB; mp.B = (const char*)(WGU + (size_t)layer * 2 * DFF * D); mp.astep = MK_STEP; mp.bstep = MK_STEP;
            EpiSwiglu E{HF, RINV};
            gemm_phase<EpiSwiglu, MapReg<M / BM, (2 * DFF) / BM, 128>, MK_ALIGN>(lds, mp, E, D, D, D); }
        GRID_BAR();
        if (PH(14)) REP(14) {   MapReg<M / BM, D / BM, BM> mp; mp.A = (const char*)HF; mp.B = (const char*)(WDN + (size_t)layer * D * DFF); mp.astep = (size_t)BM * DFF * 2; mp.bstep = (size_t)BM * DFF * 2;
            EpiPlain<true> E{HB, D, SSP, nullptr};
            gemm_phase<EpiPlain<true>, MapReg<M / BM, D / BM, BM>, MK_ALIGN>(lds, mp, E, DFF, DFF, DFF); }
        GRID_BAR();
        if (layer < DEPTH - 1) { if (PH(8)) row_pass<false>(make_frame(lds), XB, HB, SSP, norm_gains + ((size_t)layer * 6 + 5) * D, RINV, nullptr); GRID_BAR(); }
        else if (PH(15)) row_pass<true>(make_frame(lds), XB, HB, SSP, norm_gains + ((size_t)layer * 6 + 5) * D, nullptr, X);
    }
}
}

static void mk_launch(void* const* d_in, void* d_out, void* d_ws, size_t ws_size, hipStream_t stream) {
    static int ok = 0;
    if (ok == 0) {
        ok = -1;
        if (ws_size < mk::WS_END) { fprintf(stderr, "kernel_launch: workspace too small (%zu < %zu)\n", ws_size, (size_t)mk::WS_END); return; }
        if (hipFuncSetAttribute((const void*)mk::mega_fwd, hipFuncAttributeMaxDynamicSharedMemorySize, mk::LDS_BYTES) != hipSuccess) { fprintf(stderr, "kernel_launch: hipFuncSetAttribute failed\n"); return; }
        int dev = 0, cus = 0, per_cu = 0;
        (void)hipGetDevice(&dev); (void)hipDeviceGetAttribute(&cus, hipDeviceAttributeMultiprocessorCount, dev);
        (void)hipOccupancyMaxActiveBlocksPerMultiprocessor(&per_cu, (const void*)mk::mega_fwd, mk::NTHREADS, mk::LDS_BYTES);
        (void)hipGetLastError();
        if (cus < mk::GRID || per_cu < 1) { fprintf(stderr, "kernel_launch: needs %d CUs with one resident block each (cus %d, per_cu %d)\n", mk::GRID, cus, per_cu); return; }
        ok = 1;
    }
    if (ok < 0) return;
    (void)hipMemsetAsync((char*)d_ws + mk::WS_CTL, 0, mk::CTL_BYTES, stream);
    mk::Args a{};
    for (int i = 0; i < 21; ++i) a.in[i] = (const float*)d_in[i];
    a.out = (float*)d_out; a.ws = (unsigned char*)d_ws;
    hipLaunchKernelGGL(mk::mega_fwd, dim3(mk::GRID), dim3(mk::NTHREADS), mk::LDS_BYTES, stream, a);
}

extern "C" void kernel_launch(void* const* d_in, const int* in_sizes, int n_in, void* d_out, int out_size, void* d_ws, size_t ws_size, hipStream_t stream) {
    (void)in_sizes; (void)n_in; (void)out_size;
    mk_launch(d_in, d_out, d_ws, ws_size, stream);
}
```

```cpp
#include <hip/hip_runtime.h>
#include <cstdio>
#include <cstdint>

namespace mk {
#define LAS __attribute__((address_space(3)))
#define GAS __attribute__((address_space(1)))
typedef unsigned short bf16_t;
typedef short bf16x8 __attribute__((ext_vector_type(8)));
typedef float f32x4 __attribute__((ext_vector_type(4)));
typedef float f32x2 __attribute__((ext_vector_type(2)));
typedef unsigned u32x4 __attribute__((ext_vector_type(4)));
typedef unsigned u32x2 __attribute__((ext_vector_type(2)));

constexpr int D = 2048, SEQ = 2048, NB = 12, M = NB * SEQ, DEPTH = 4, NMEM = 256, MM = NB * NMEM, DFF = 5632, NH = 4, HD = 512, DG = 2048;
constexpr int NPROMPT_ROWS = 4 * SEQ, NPROMPT_MEM = 4 * NMEM;
constexpr float EPS = 1e-6f;
constexpr int NWAVES = 8, NTHREADS = 512, GRID = 256;
#ifndef PHASES
#define PHASES 0xFFFFF
#endif
#define PH(b) ((PHASES >> (b)) & 1)
#ifndef MK_ALIGN
#define MK_ALIGN false
#endif
#ifndef EPI2
#define EPI2 0
#endif
#ifndef PORDER
#define PORDER 0
#endif
#ifndef STAG
#define STAG 0
#endif
#ifndef NSTAG
#define NSTAG 4
#endif
#ifndef EPI_NT
#define EPI_NT 0
#endif
#if EPI_NT
#define EPI_STORE(p, v) __builtin_nontemporal_store((v), (p))
#else
#define EPI_STORE(p, v) (*(p) = (v))
#endif
#ifndef MK_SP2
#define MK_SP2 1
#endif
#ifndef BARX2
#define BARX2 0
#endif
#ifndef ROWPROBE
#define ROWPROBE 0
#endif
#ifndef REPEAT
#define REPEAT 0
#endif
#define REP(b) for (int _r = 0; _r < 1 + ((REPEAT >> (b)) & 1); ++_r)

constexpr size_t MiB = 1u << 20;
constexpr size_t WS_CTL = 0, CTL_BYTES = 1 * MiB;
constexpr size_t WS_WPOOL = 1 * MiB;
constexpr size_t WS_WS = WS_WPOOL + 4 * MiB;
constexpr size_t WS_WIN = WS_WS + 1 * MiB;
constexpr size_t WS_WOUT = WS_WIN + 32 * MiB;
constexpr size_t WS_WQ = WS_WOUT + 16 * MiB;
constexpr size_t WS_WK = WS_WQ + 32 * MiB;
constexpr size_t WS_WV = WS_WK + 32 * MiB;
constexpr size_t WS_WO = WS_WV + 32 * MiB;
constexpr size_t WS_WGU = WS_WO + 32 * MiB;
constexpr size_t WS_WDN = WS_WGU + 176 * MiB;
constexpr size_t WS_MEMBN = WS_WDN + 88 * MiB;
constexpr size_t WS_KMAT = WS_MEMBN + 12 * MiB;
constexpr size_t WS_VT = WS_KMAT + 48 * MiB;
constexpr size_t WS_XB = WS_VT + 48 * MiB;
constexpr size_t WS_HB = WS_XB + 96 * MiB;
constexpr size_t WS_BIG = WS_HB + 96 * MiB;
constexpr size_t WS_SSP = WS_BIG + 264 * MiB;
constexpr size_t WS_VST = WS_SSP + 3 * MiB;
constexpr size_t WS_RSP = WS_VST + 6 * MiB;
constexpr size_t WS_RINV = WS_RSP + 2 * MiB;
constexpr size_t WS_END = WS_RINV + 1 * MiB;
constexpr size_t BIG_U = 0, BIG_V = 96 * MiB, BIG_DA = 0, BIG_MT = 0, BIG_VWT = 48 * MiB, BIG_PT = 192 * MiB, BIG_HF = 0;
constexpr int CW_BAR = 4096;

constexpr int RING_BYTES = 131072, RED_OFF = RING_BYTES, RED2_OFF = RED_OFF + 4096, RDMA_OFF = RED_OFF + 8192, MISC_OFF = RED_OFF + 12288, LDS_BYTES = 147456;

#define LDS_WAIT() asm volatile("s_waitcnt lgkmcnt(0)" ::: "memory")
#define VM_WAIT() asm volatile("s_waitcnt vmcnt(0)" ::: "memory")

#define XB_TMO      128
#define XB_XCNT(j)  (256  + 64 * (j))
#define XB_XSUB(j)  (1280 + 64 * (j))
#define XB_XGEN(j)  (2304 + 64 * (j))
#define XB_TOP      3328
#define XB_TOPGEN   3392
#define XCD_BAR_WORDS 3456
#define XB_SPIN_CAP (1u << 18)
__device__ __forceinline__ unsigned xb_ld(unsigned* p)              { return __hip_atomic_load(p, __ATOMIC_RELAXED, __HIP_MEMORY_SCOPE_AGENT); }
__device__ __forceinline__ unsigned xb_add(unsigned* p, unsigned v) { return __hip_atomic_fetch_add(p, v, __ATOMIC_RELAXED, __HIP_MEMORY_SCOPE_AGENT); }
__device__ __forceinline__ unsigned xb_xcc_id() { return (unsigned)__builtin_amdgcn_s_getreg((3 << 11) | 20) & 0xFu; }
#define XB_SPIN(cond, bar) do { unsigned _sp = 0; while (cond) { __builtin_amdgcn_s_sleep(1); \
    if ((++_sp & 255u) == 0u) { if (xb_ld(&(bar)[XB_TMO])) break; if (_sp > XB_SPIN_CAP) { atomicAdd(&(bar)[XB_TMO], 1u); break; } } } } while (0)
struct XcdBarrier { unsigned* bar; unsigned x; volatile LAS unsigned* st; };
__device__ __forceinline__ XcdBarrier xcd_barrier_post(unsigned* bar, volatile LAS unsigned* st) {
    XcdBarrier b; b.bar = bar; b.x = xb_xcc_id(); b.st = st;
    if (threadIdx.x == 0) (void)xb_add(&bar[XB_XCNT(b.x)], 1u);
    return b;
}
__device__ __forceinline__ void xcd_barrier_complete(unsigned* bar, unsigned x, unsigned& nloc, unsigned& nx) {
    const unsigned G = gridDim.x * gridDim.y * gridDim.z;
    unsigned sum, cnt, mine, sp = 0u;
    for (;;) {
        sum = 0u; cnt = 0u; mine = 0u;
#pragma unroll
        for (unsigned j = 0; j < 16; ++j) { const unsigned c = xb_ld(&bar[XB_XCNT(j)]); sum += c; cnt += (c > 0u) ? 1u : 0u; mine = (j == x) ? c : mine; }
        if (sum == G) break;
        __builtin_amdgcn_s_sleep(1);
        if ((++sp & 255u) == 0u) { if (xb_ld(&bar[XB_TMO])) break; if (sp > XB_SPIN_CAP) { atomicAdd(&bar[XB_TMO], 1u); break; } }
    }
    nloc = mine > 0u ? mine : 1u; nx = cnt > 0u ? cnt : 1u;
}
__device__ __forceinline__ void xcd_barrier(const XcdBarrier& b) {
    asm volatile("s_waitcnt vmcnt(0)" ::: "memory");
    __syncthreads();
    if (threadIdx.x == 0) {
        unsigned* bar = b.bar;
        __builtin_amdgcn_s_waitcnt(0);
        unsigned nloc = b.st[0], nx = b.st[1];
        if (nloc == 0u) { xcd_barrier_complete(bar, b.x, nloc, nx); b.st[0] = nloc; b.st[1] = nx; }
        const unsigned old = xb_add(&bar[XB_XSUB(b.x)], 1u);
        const unsigned gen = old / nloc;
        if (old + 1u == (gen + 1u) * nloc) {
            __builtin_amdgcn_fence(__ATOMIC_RELEASE, "agent");
            asm volatile("s_waitcnt vmcnt(0)" ::: "memory");
            const unsigned og = xb_add(&bar[XB_TOP], 1u);
            const unsigned tg = og / nx;
            if (og + 1u == (tg + 1u) * nx) xb_add(&bar[XB_TOPGEN], 1u);
            else XB_SPIN(xb_ld(&bar[XB_TOPGEN]) == tg, bar);
            __builtin_amdgcn_fence(__ATOMIC_ACQUIRE, "agent");
            xb_add(&bar[XB_XGEN(b.x)], 1u);
            asm volatile("s_waitcnt vmcnt(0)" ::: "memory");
        } else {
            XB_SPIN(xb_ld(&bar[XB_XGEN(b.x)]) == gen, bar);
            __builtin_amdgcn_fence(__ATOMIC_ACQUIRE, "agent");
            asm volatile("s_waitcnt vmcnt(0)" ::: "memory");
        }
    }
    __syncthreads();
}

__device__ __forceinline__ unsigned cvt_pk_bf16(float lo, float hi) { unsigned r; asm volatile("v_cvt_pk_bf16_f32 %0, %1, %2" : "=v"(r) : "v"(lo), "v"(hi)); return r; }
__device__ __forceinline__ float bf_lo(unsigned w) { return __uint_as_float(w << 16); }
__device__ __forceinline__ float bf_hi(unsigned w) { return __uint_as_float(w & 0xffff0000u); }
__device__ __forceinline__ float wave_sum(float v) {
#pragma unroll
    for (int o = 1; o < 64; o <<= 1) v += __shfl_xor(v, o);
    return v;
}
__device__ __forceinline__ float fast_exp(float x) { return __builtin_amdgcn_exp2f(x * 1.4426950408889634f); }
__device__ __forceinline__ float gelu_tanh_f(float x) {
    const float u = x * (1.5957691216057308f + 0.07135481282803448f * x * x);
    return x * __builtin_amdgcn_rcpf(1.f + fast_exp(-u));
}
__device__ __forceinline__ float silu_f(float x) { return x * __builtin_amdgcn_rcpf(1.f + fast_exp(-x)); }

constexpr int BM = 256, BK = 64, HALF = 128, HTB = HALF * BK * 2, NXCD = 8, WGM = 8;
__device__ __forceinline__ int lds_byte(int r, int c) { const int st = (r >> 4) * 2 + (c >> 5), rr = r & 15, cc = c & 31, ob = rr * 64 + cc * 2; return st * 1024 + (ob ^ (((ob >> 9) & 1) << 5)); }
__device__ __forceinline__ void stage_rc(int b, int& R, int& C) { const int st = b / 1024, sb = b % 1024, swz = sb ^ (((sb >> 9) & 1) << 5); R = (st >> 1) * 16 + swz / 64; C = (st & 1) * 32 + (swz % 64) / 2; }
__device__ __forceinline__ int perm32(int rho) { const int n = rho >> 4, i = rho & 15; return 8 * (i >> 2) + 4 * n + (i & 3); }

struct GU { const char* A; const char* B; int r0, c0, aux; };
struct Tile { int pm, pn; };
template <int nM, int nN> struct Order {
    static constexpr int nwg = nM * nN, G = GRID;
    __device__ __forceinline__ bool tile(int i, Tile& t) const {
        int c = (int)blockIdx.x; asm volatile("" : "+s"(c));
        const long L = (long)i * G + c; if (L >= nwg) return false;
        int wgid = (int)L; { const int q = nwg / NXCD, r = nwg % NXCD, xcd = wgid % NXCD, off = wgid / NXCD; wgid = (xcd < r ? xcd * (q + 1) : r * (q + 1) + (xcd - r) * q) + off; }
        const int nig = WGM * nN, gid = wgid / nig, fm = gid * WGM, gsz = (nM - fm) < WGM ? (nM - fm) : WGM;
        t.pm = fm + ((wgid % nig) % gsz); t.pn = (wgid % nig) / gsz; return true;
    }
};
template <class Epi, class Map, bool ALIGN_EPI>
__device__ __forceinline__ void gemm_phase(LAS unsigned char* lds, const Map& S, const Epi& E, const int K, const int lda, const int ldb) {
    int tid_ = threadIdx.x; asm volatile("" : "+v"(tid_));
    const int tid = tid_, wid = __builtin_amdgcn_readfirstlane(tid >> 6), lane = tid & 63, wr = wid >> 2, wc = wid & 3, fr = lane & 15, fq = lane >> 4;
    const int nt = K / BK;
    unsigned voffA[2], voffB[2];
#pragma unroll
    for (int i = 0; i < 2; ++i) { int R, C; stage_rc(tid * 16 + i * 8192, R, C); const int Rb = (R & ~31) + perm32(R & 31);
        voffA[i] = (unsigned)(R * lda + C) * 2u; voffB[i] = (unsigned)(Rb * ldb + C) * 2u; }
    const size_t kstep = (size_t)(BK * 2);
    const size_t hstepA = (size_t)HALF * lda * 2, hstepB = (size_t)HALF * ldb * 2;
    const unsigned ldsw = (unsigned)wid * 1024u;
    const int aoff = lds_byte(wr * 64 + fr, fq * 8), boff = lds_byte(wc * 32 + fr, fq * 8);
#define PG8_SA(b, h) (((b) * 2 + (h)) * HTB)
#define PG8_SB(b, h) ((4 + (b) * 2 + (h)) * HTB)
#define PG8_STAGE(bufoff, gbase, voff) do { _Pragma("unroll") for (int _i = 0; _i < 2; ++_i) \
        __builtin_amdgcn_global_load_lds((const unsigned*)((const char*)(gbase) + (voff)[_i]), (LAS unsigned*)(lds + (bufoff) + ldsw + _i * 8192), 16, 0, 0); } while (0)
#define PG8_LDA(dst, b, h) do { _Pragma("unroll") for (int m = 0; m < 4; ++m) _Pragma("unroll") for (int k = 0; k < 2; ++k) dst[m][k] = *(const LAS bf16x8*)(lds + PG8_SA(b, h) + aoff + m * 2048 + k * 1024); } while (0)
#define PG8_LDB(dst, b, h) do { _Pragma("unroll") for (int n = 0; n < 2; ++n) _Pragma("unroll") for (int k = 0; k < 2; ++k) dst[n][k] = *(const LAS bf16x8*)(lds + PG8_SB(b, h) + boff + n * 2048 + k * 1024); } while (0)
#define PG8_MMA(ai, bj, At, Bt) do { __builtin_amdgcn_s_setprio(1); _Pragma("unroll") for (int m = 0; m < 4; ++m) _Pragma("unroll") for (int n = 0; n < 2; ++n) _Pragma("unroll") for (int k = 0; k < 2; ++k) \
        acc[ai][bj][m][n] = __builtin_amdgcn_mfma_f32_16x16x32_bf16(Bt[n][k], At[m][k], acc[ai][bj][m][n], 0, 0, 0); __builtin_amdgcn_s_setprio(0); } while (0)
#define PG8_WAIT_V(n) asm volatile("s_waitcnt vmcnt(" #n ")" ::: "memory")
#define PG8_WAIT_L(n) asm volatile("s_waitcnt lgkmcnt(" #n ")" ::: "memory")
#define PG8_BAR __builtin_amdgcn_s_barrier()
#define PG8_SCHED __builtin_amdgcn_sched_barrier(0)
    GU cur, nxt; int ui = 0;
    if (!S.next(0, cur)) return;
    if (STAG > 0) {
        int bx = (int)blockIdx.x; asm volatile("" : "+s"(bx)); const unsigned long long dl = (unsigned long long)(((bx >> 3) % NSTAG) * STAG);
        const unsigned long long t0 = __builtin_amdgcn_s_memrealtime(); while (__builtin_amdgcn_s_memrealtime() - t0 < dl) __builtin_amdgcn_s_sleep(2); }
    f32x4 acc[2][2][4][2];
#pragma unroll
    for (int a = 0; a < 2; ++a)
#pragma unroll
        for (int b = 0; b < 2; ++b)
#pragma unroll
            for (int m = 0; m < 4; ++m)
#pragma unroll
                for (int n = 0; n < 2; ++n) acc[a][b][m][n] = (f32x4){0.f, 0.f, 0.f, 0.f};
    bf16x8 At[4][2], B0[2][2], B1[2][2];
    const char* cA = cur.A; const char* cB = cur.B;
    E.prefetch(cur, wr, wc, lane, lds);
#if MK_SP2
    PG8_STAGE(PG8_SB(0, 0), cB, voffB); PG8_STAGE(PG8_SB(0, 1), cB + hstepB, voffB); PG8_STAGE(PG8_SA(0, 0), cA, voffA); PG8_STAGE(PG8_SA(0, 1), cA + hstepA, voffA);
    if (wr == 1) PG8_BAR;
    PG8_WAIT_V(2); PG8_BAR;
#else
    PG8_STAGE(PG8_SB(0, 0), cB, voffB); PG8_STAGE(PG8_SA(0, 0), cA, voffA); PG8_STAGE(PG8_SB(0, 1), cB + hstepB, voffB); PG8_STAGE(PG8_SA(0, 1), cA + hstepA, voffA);
    if (wr == 1) PG8_BAR;
    PG8_WAIT_V(4); PG8_BAR;
#endif
    PG8_STAGE(PG8_SB(1, 0), cB + kstep, voffB); PG8_STAGE(PG8_SA(1, 0), cA + kstep, voffA); PG8_STAGE(PG8_SB(1, 1), cB + hstepB + kstep, voffB);
    PG8_WAIT_V(6); PG8_BAR;
    for (;;) {
        const bool has_next = S.next(ui + 1, nxt);
        const char* nA = has_next ? nxt.A : cA; const char* nB = has_next ? nxt.B : cB;
        for (int t = 0; t < nt; t += 2) {
            const bool last = (t == nt - 2);
            const char* a1 = cA + (size_t)(t + 1) * kstep;
            const char* a2 = last ? nA : cA + (size_t)(t + 2) * kstep; const char* b2 = last ? nB : cB + (size_t)(t + 2) * kstep;
            const char* a3 = a2 + kstep; const char* b3 = b2 + kstep;
#if MK_SP2
            PG8_LDB(B0, 0, 0); PG8_LDB(B1, 0, 1); PG8_SCHED; PG8_LDA(At, 0, 0); PG8_STAGE(PG8_SA(1, 1), a1 + hstepA, voffA);
            PG8_WAIT_V(8); PG8_WAIT_L(0); PG8_BAR; PG8_MMA(0, 0, At, B0); PG8_MMA(0, 1, At, B1); PG8_BAR; PG8_SCHED;
            PG8_LDA(At, 0, 1); PG8_STAGE(PG8_SB(0, 0), b2, voffB); PG8_STAGE(PG8_SB(0, 1), b2 + hstepB, voffB); PG8_STAGE(PG8_SA(0, 0), a2, voffA);
            PG8_WAIT_V(8); PG8_WAIT_L(0); PG8_BAR; PG8_MMA(1, 0, At, B0); PG8_MMA(1, 1, At, B1); PG8_BAR; PG8_SCHED;
            PG8_LDB(B0, 1, 0); PG8_LDB(B1, 1, 1); PG8_SCHED; PG8_LDA(At, 1, 0); PG8_STAGE(PG8_SA(0, 1), a2 + hstepA, voffA);
            PG8_WAIT_V(8); PG8_WAIT_L(0); PG8_BAR; PG8_MMA(0, 0, At, B0); PG8_MMA(0, 1, At, B1); PG8_BAR; PG8_SCHED;
            PG8_LDA(At, 1, 1); PG8_STAGE(PG8_SB(1, 0), b3, voffB); PG8_STAGE(PG8_SB(1, 1), b3 + hstepB, voffB); PG8_STAGE(PG8_SA(1, 0), a3, voffA);
            PG8_WAIT_V(8); PG8_WAIT_L(0); PG8_BAR; PG8_MMA(1, 0, At, B0); PG8_MMA(1, 1, At, B1); PG8_BAR; PG8_SCHED;
        #else
            PG8_LDB(B0, 0, 0); PG8_SCHED; PG8_LDA(At, 0, 0); PG8_STAGE(PG8_SA(1, 1), a1 + hstepA, voffA);
            PG8_WAIT_L(8); PG8_BAR; PG8_WAIT_L(0); PG8_MMA(0, 0, At, B0); PG8_BAR; PG8_SCHED;
            PG8_LDB(B1, 0, 1); PG8_STAGE(PG8_SB(0, 0), b2, voffB);
            PG8_BAR; PG8_WAIT_L(0); PG8_MMA(0, 1, At, B1); PG8_BAR;
            PG8_LDA(At, 0, 1); PG8_STAGE(PG8_SA(0, 0), a2, voffA);
            PG8_BAR; PG8_WAIT_L(0); PG8_MMA(1, 0, At, B0); PG8_BAR; PG8_SCHED;
            PG8_STAGE(PG8_SB(0, 1), b2 + hstepB, voffB);
            PG8_WAIT_V(6); PG8_BAR; PG8_MMA(1, 1, At, B1); PG8_BAR;
            PG8_LDB(B0, 1, 0); PG8_SCHED; PG8_LDA(At, 1, 0); PG8_STAGE(PG8_SA(0, 1), a2 + hstepA, voffA);
            PG8_WAIT_L(8); PG8_BAR; PG8_WAIT_L(0); PG8_MMA(0, 0, At, B0); PG8_BAR; PG8_SCHED;
            PG8_LDB(B1, 1, 1); PG8_STAGE(PG8_SB(1, 0), b3, voffB);
            PG8_BAR; PG8_WAIT_L(0); PG8_MMA(0, 1, At, B1); PG8_BAR;
            PG8_LDA(At, 1, 1); PG8_STAGE(PG8_SA(1, 0), a3, voffA);
            PG8_BAR; PG8_WAIT_L(0); PG8_MMA(1, 0, At, B0); PG8_BAR; PG8_SCHED;
            PG8_STAGE(PG8_SB(1, 1), b3 + hstepB, voffB);
            PG8_WAIT_V(6); PG8_BAR; PG8_MMA(1, 1, At, B1); PG8_BAR;
#endif
        }
        if constexpr (ALIGN_EPI) { if (wr == 0) PG8_BAR; }
        E(acc, cur, wr, wc, fr, fq, lds);
        if (EPI2) E(acc, cur, wr, wc, fr, fq, lds);
        if (!has_next) break;
#pragma unroll
        for (int a = 0; a < 2; ++a)
#pragma unroll
            for (int b = 0; b < 2; ++b)
#pragma unroll
                for (int m = 0; m < 4; ++m)
#pragma unroll
                    for (int n = 0; n < 2; ++n) acc[a][b][m][n] = (f32x4){0.f, 0.f, 0.f, 0.f};
        cur = nxt; cA = nA; cB = nB; ++ui;
        E.prefetch(cur, wr, wc, lane, lds);
        if constexpr (ALIGN_EPI) { if (wr == 1) PG8_BAR; }
    }
    PG8_WAIT_V(0);
    if constexpr (!ALIGN_EPI) { if (wr == 0) PG8_BAR; }
    PG8_BAR;
#undef PG8_SA
#undef PG8_SB
#undef PG8_STAGE
#undef PG8_LDA
#undef PG8_LDB
#undef PG8_MMA
#undef PG8_WAIT_V
#undef PG8_WAIT_L
#undef PG8_BAR
#undef PG8_SCHED
}

template <int nM, int nN, int c0mul> struct MapReg {
    Order<nM, nN> o; const char* A; const char* B; size_t astep, bstep;
    __device__ __forceinline__ bool next(int i, GU& u) const { Tile t; if (!o.tile(i, t)) return false;
        u.A = A + (size_t)t.pm * astep; u.B = B + (size_t)t.pn * bstep; u.r0 = t.pm * BM; u.c0 = t.pn * c0mul; u.aux = t.pn; return true; }
};
struct MapPool {
    Order<M / BM, D / BM> o; const char* A; const char* B;
    __device__ __forceinline__ bool next(int i, GU& u) const { Tile t; if (!o.tile(i, t)) return false;
        u.A = A + ((size_t)t.pm * BM * D + (size_t)(t.pn >> 1) * 512) * 2; u.B = B + (size_t)t.pn * BM * 512 * 2; u.r0 = t.pm * BM; u.c0 = t.pn * BM; u.aux = t.pn; return true; }
};
struct MapKV { Order<MM / BM, 64> o; const char* A; const char* B;
    __device__ __forceinline__ bool next(int i, GU& u) const { Tile t; if (!o.tile(i, t)) return false;
        u.A = A + (size_t)t.pm * BM * D * 2; u.B = B + (size_t)t.pn * BM * D * 2; u.r0 = (t.pn >> 3) * MM + t.pm * BM; u.c0 = (t.pn & 7) * BM; u.aux = 0; return true; }
};
struct MapMT { Order<48, 8> o; const char* Kl; const char* Wq;
    __device__ __forceinline__ bool next(int i, GU& u) const { Tile t; if (!o.tile(i, t)) return false;
        const int bh = t.pm, b = bh >> 2, h = bh & 3;
        u.A = Kl + ((size_t)b * NMEM * D + (size_t)h * HD) * 2; u.B = Wq + ((size_t)t.pn * BM * D + (size_t)h * HD) * 2; u.r0 = bh * NMEM; u.c0 = t.pn * BM; u.aux = 0; return true; }
};
struct MapVWT2 { const char* Vl; const char* Wo;
    __device__ __forceinline__ bool next(int i, GU& u) const { int c = (int)blockIdx.x; asm volatile("" : "+s"(c)); if (c < 128 || i >= 3) return false;
        const int idx = (c - 128) * 3 + i, bh = idx >> 3, pn = idx & 7, b = bh >> 2, h = bh & 3;
        u.A = Wo + ((size_t)pn * BM * D + (size_t)h * HD) * 2; u.B = Vl + ((size_t)b * NMEM * D + (size_t)h * HD) * 2; u.r0 = b * D + pn * BM; u.c0 = h * NMEM; u.aux = 1; return true; }
};
struct MapS2 {
    Order<M / BM, NH> o; const char* Xp; const char* MTp;
    __device__ __forceinline__ bool next(int i, GU& u) const { Tile t; if (!o.tile(i, t)) return false;
        u.A = Xp + (size_t)t.pm * BM * D * 2; u.B = MTp + (size_t)((t.pm >> 3) * NH + t.pn) * NMEM * D * 2; u.r0 = t.pm * BM; u.c0 = t.pn * NMEM; u.aux = t.pn; return true; }
};
struct MapPVO {
    Order<M / BM, D / BM> o; const char* P; const char* VW;
    __device__ __forceinline__ bool next(int i, GU& u) const { Tile t; if (!o.tile(i, t)) return false;
        u.A = P + (size_t)t.pm * BM * 1024 * 2; u.B = VW + ((size_t)(t.pm >> 3) * D + (size_t)t.pn * BM) * 1024 * 2; u.r0 = t.pm * BM; u.c0 = t.pn * BM; u.aux = t.pn; return true; }
};

__device__ __forceinline__ void rinv_dma(const float* rinv, const GU& u, int wr, int wc, int lane, LAS unsigned char* lds) {
    LAS unsigned char* dst = lds + RDMA_OFF + (wr * 4 + wc) * 512;
#pragma unroll
    for (int ai = 0; ai < 2; ++ai)
        __builtin_amdgcn_global_load_lds((const unsigned*)(rinv + u.r0 + ai * HALF + wr * 64 + lane), (LAS unsigned*)(dst + ai * 256), 4, 0, 0);
}
__device__ __forceinline__ float rinv_lds(LAS unsigned char* lds, int wr, int wc, int ai, int m, int fr) { return *(const LAS float*)(lds + RDMA_OFF + (wr * 4 + wc) * 512 + ai * 256 + (m * 16 + fr) * 4); }

template <bool SS, bool RS = false> struct EpiPlain {
    bf16_t* O; int ldc; float* ssp; const float* rinv;
    __device__ __forceinline__ void prefetch(const GU& u, int wr, int wc, int lane, LAS unsigned char* lds) const { if (RS) rinv_dma(rinv, u, wr, wc, lane, lds); }
    __device__ __forceinline__ void operator()(const f32x4 (&acc)[2][2][4][2], const GU& u, int wr, int wc, int fr, int fq, LAS unsigned char* lds) const {
        const int row0 = u.r0 + wr * 64 + fr, col0 = u.c0 + wc * 32 + 8 * fq;
#pragma unroll
        for (int ai = 0; ai < 2; ++ai)
#pragma unroll
            for (int m = 0; m < 4; ++m) { const int row = row0 + ai * HALF + m * 16; bf16_t* rowp = O + (size_t)row * ldc + col0; float s = 0.f;
                const float r = RS ? rinv_lds(lds, wr, wc, ai, m, fr) : 1.f;
#pragma unroll
                for (int bj = 0; bj < 2; ++bj) { f32x4 v0 = acc[ai][bj][m][0], v1 = acc[ai][bj][m][1];
                    if (RS) { v0 = v0 * r; v1 = v1 * r; }
                    if (SS) s += (v0[0] * v0[0] + v0[1] * v0[1]) + (v0[2] * v0[2] + v0[3] * v0[3]) + (v1[0] * v1[0] + v1[1] * v1[1]) + (v1[2] * v1[2] + v1[3] * v1[3]);
                    u32x4 w; w.x = cvt_pk_bf16(v0[0], v0[1]); w.y = cvt_pk_bf16(v0[2], v0[3]); w.z = cvt_pk_bf16(v1[0], v1[1]); w.w = cvt_pk_bf16(v1[2], v1[3]);
                    EPI_STORE((u32x4*)(rowp + bj * HALF), w); }
                if (SS) { s += __shfl_xor(s, 16); s += __shfl_xor(s, 32); if (fq == 0) ssp[(size_t)row * 32 + (u.c0 >> 8) * 4 + wc] = s; } }
    }
};
struct EpiGeluUV {
    bf16_t* U; bf16_t* V; float* vst; const float* rinv;
    __device__ __forceinline__ void prefetch(const GU& u, int wr, int wc, int lane, LAS unsigned char* lds) const { rinv_dma(rinv, u, wr, wc, lane, lds); }
    __device__ __forceinline__ void operator()(const f32x4 (&acc)[2][2][4][2], const GU& u, int wr, int wc, int fr, int fq, LAS unsigned char* lds) const {
        const bool isv = u.c0 >= DG; const int cbase = isv ? u.c0 - DG : u.c0; bf16_t* O = isv ? V : U;
        const int row0 = u.r0 + wr * 64 + fr, col0 = cbase + wc * 32 + 8 * fq;
#pragma unroll
        for (int ai = 0; ai < 2; ++ai)
#pragma unroll
            for (int m = 0; m < 4; ++m) { const int row = row0 + ai * HALF + m * 16; bf16_t* rowp = O + (size_t)row * DG + col0; float s = 0.f, q = 0.f;
                const float r = rinv_lds(lds, wr, wc, ai, m, fr);
#pragma unroll
                for (int bj = 0; bj < 2; ++bj) { f32x4 v0 = acc[ai][bj][m][0], v1 = acc[ai][bj][m][1];
#pragma unroll
                    for (int e = 0; e < 4; ++e) { v0[e] = gelu_tanh_f(v0[e] * r); v1[e] = gelu_tanh_f(v1[e] * r); }
                    s += (v0[0] + v0[1]) + (v0[2] + v0[3]) + (v1[0] + v1[1]) + (v1[2] + v1[3]);
                    q += (v0[0] * v0[0] + v0[1] * v0[1]) + (v0[2] * v0[2] + v0[3] * v0[3]) + (v1[0] * v1[0] + v1[1] * v1[1]) + (v1[2] * v1[2] + v1[3] * v1[3]);
                    u32x4 w; w.x = cvt_pk_bf16(v0[0], v0[1]); w.y = cvt_pk_bf16(v0[2], v0[3]); w.z = cvt_pk_bf16(v1[0], v1[1]); w.w = cvt_pk_bf16(v1[2], v1[3]);
                    EPI_STORE((u32x4*)(rowp + bj * HALF), w); }
                if (isv) { s += __shfl_xor(s, 16); s += __shfl_xor(s, 32); q += __shfl_xor(q, 16); q += __shfl_xor(q, 32);
                    if (fq == 0) *(f32x2*)(vst + ((size_t)row * 32 + (cbase >> 8) * 4 + wc) * 2) = (f32x2){s, q}; } }
    }
};
struct EpiSwiglu {
    bf16_t* HF; const float* rinv;
    __device__ __forceinline__ void prefetch(const GU& u, int wr, int wc, int lane, LAS unsigned char* lds) const { rinv_dma(rinv, u, wr, wc, lane, lds); }
    __device__ __forceinline__ void operator()(const f32x4 (&acc)[2][2][4][2], const GU& u, int wr, int wc, int fr, int fq, LAS unsigned char* lds) const {
        const int row0 = u.r0 + wr * 64 + fr, col0 = u.c0 + wc * 32 + 8 * fq;
#pragma unroll
        for (int ai = 0; ai < 2; ++ai)
#pragma unroll
            for (int m = 0; m < 4; ++m) { const int row = row0 + ai * HALF + m * 16; float o[8]; const float r = rinv_lds(lds, wr, wc, ai, m, fr);
#pragma unroll
                for (int n = 0; n < 2; ++n)
#pragma unroll
                    for (int e = 0; e < 4; ++e) o[n * 4 + e] = silu_f(acc[ai][0][m][n][e] * r) * (acc[ai][1][m][n][e] * r);
                u32x4 w; w.x = cvt_pk_bf16(o[0], o[1]); w.y = cvt_pk_bf16(o[2], o[3]); w.z = cvt_pk_bf16(o[4], o[5]); w.w = cvt_pk_bf16(o[6], o[7]);
                EPI_STORE((u32x4*)(HF + (size_t)row * DFF + col0), w); }
    }
};
struct EpiMTVWT {
    static constexpr int NS = 16, R2 = 0;
    bf16_t* MTp; bf16_t* VWp;
    __device__ __forceinline__ void prefetch(const GU&, int, int, int, LAS unsigned char*) const {}
    __device__ __forceinline__ void operator()(const f32x4 (&acc)[2][2][4][2], const GU& u, int wr, int wc, int fr, int fq, LAS unsigned char*) const {
        bf16_t* O = u.aux ? VWp : MTp; const int ldc = u.aux ? 1024 : D;
        const int row0 = u.r0 + wr * 64 + fr, col0 = u.c0 + wc * 32 + 8 * fq;
#pragma unroll
        for (int ai = 0; ai < 2; ++ai)
#pragma unroll
            for (int m = 0; m < 4; ++m) { bf16_t* rowp = O + (size_t)(row0 + ai * HALF + m * 16) * ldc + col0;
#pragma unroll
                for (int bj = 0; bj < 2; ++bj) { const f32x4 v0 = acc[ai][bj][m][0], v1 = acc[ai][bj][m][1];
                    u32x4 w; w.x = cvt_pk_bf16(v0[0], v0[1]); w.y = cvt_pk_bf16(v0[2], v0[3]); w.z = cvt_pk_bf16(v1[0], v1[1]); w.w = cvt_pk_bf16(v1[2], v1[3]);
                    *(u32x4*)(rowp + bj * HALF) = w; } }
    }
};
struct EpiSoftmax2 {
    static constexpr int NS = 16, R2 = 2;
    bf16_t* PT; const float* rinv;
    __device__ __forceinline__ void prefetch(const GU& u, int wr, int wc, int lane, LAS unsigned char* lds) const { rinv_dma(rinv, u, wr, wc, lane, lds); }
    __device__ __forceinline__ void operator()(f32x4 (&acc)[2][2][4][2], const GU& u, int wr, int wc, int fr, int fq, LAS unsigned char* lds) const {
        LAS float* red = (LAS float*)(lds + RED_OFF); LAS float* red2 = (LAS float*)(lds + RED2_OFF);
        constexpr float L2E = 1.4426950408889634f;
#pragma unroll
        for (int ai = 0; ai < 2; ++ai)
#pragma unroll
            for (int m = 0; m < 4; ++m) { const float r = rinv_lds(lds, wr, wc, ai, m, fr) * L2E; float mx = -3.0e38f;
#pragma unroll
                for (int bj = 0; bj < 2; ++bj)
#pragma unroll
                    for (int n = 0; n < 2; ++n) { acc[ai][bj][m][n] = acc[ai][bj][m][n] * r;
#pragma unroll
                        for (int e = 0; e < 4; ++e) mx = fmaxf(mx, acc[ai][bj][m][n][e]); }
                mx = fmaxf(mx, __shfl_xor(mx, 16)); mx = fmaxf(mx, __shfl_xor(mx, 32));
                if (fq == 0) red[(ai * HALF + wr * 64 + m * 16 + fr) * 4 + wc] = mx; }
        asm volatile("s_waitcnt lgkmcnt(0)" ::: "memory"); __builtin_amdgcn_s_barrier(); asm volatile("" ::: "memory");
#pragma unroll
        for (int ai = 0; ai < 2; ++ai)
#pragma unroll
            for (int m = 0; m < 4; ++m) { const int rl = ai * HALF + wr * 64 + m * 16 + fr;
                const f32x4 r4 = *(const LAS f32x4*)(red + rl * 4); const float mx = fmaxf(fmaxf(r4[0], r4[1]), fmaxf(r4[2], r4[3])); float sm = 0.f;
#pragma unroll
                for (int bj = 0; bj < 2; ++bj)
#pragma unroll
                    for (int n = 0; n < 2; ++n) {
#pragma unroll
                        for (int e = 0; e < 4; ++e) { const float p = __builtin_amdgcn_exp2f(acc[ai][bj][m][n][e] - mx); acc[ai][bj][m][n][e] = p; sm += p; } }
                sm += __shfl_xor(sm, 16); sm += __shfl_xor(sm, 32);
                if (fq == 0) red2[rl * 4 + wc] = sm; }
        asm volatile("s_waitcnt lgkmcnt(0)" ::: "memory"); __builtin_amdgcn_s_barrier(); asm volatile("" ::: "memory");
        const int row0 = u.r0 + wr * 64 + fr, col0 = u.c0 + wc * 32 + 8 * fq;
#pragma unroll
        for (int ai = 0; ai < 2; ++ai)
#pragma unroll
            for (int m = 0; m < 4; ++m) { const int rl = ai * HALF + wr * 64 + m * 16 + fr;
                const f32x4 s4 = *(const LAS f32x4*)(red2 + rl * 4); const float inv = 1.f / ((s4[0] + s4[1]) + (s4[2] + s4[3]));
                bf16_t* rowp = PT + (size_t)(row0 + ai * HALF + m * 16) * 1024 + col0;
#pragma unroll
                for (int bj = 0; bj < 2; ++bj) { const f32x4 v0 = acc[ai][bj][m][0] * inv, v1 = acc[ai][bj][m][1] * inv;
                    u32x4 w; w.x = cvt_pk_bf16(v0[0], v0[1]); w.y = cvt_pk_bf16(v0[2], v0[3]); w.z = cvt_pk_bf16(v1[0], v1[1]); w.w = cvt_pk_bf16(v1[2], v1[3]);
                    *(u32x4*)(rowp + bj * HALF) = w; } }
    }
};

struct Args { const float* in[21]; float* out; unsigned char* ws; };
struct Frame { LAS unsigned char* lds; int tid, lane, wave, vcu; static constexpr int G = GRID; };
__device__ __forceinline__ Frame make_frame(LAS unsigned char* lds) {
    Frame F; F.lds = lds; int t_ = threadIdx.x; asm volatile("" : "+v"(t_)); F.tid = t_; F.lane = F.tid & 63; F.wave = __builtin_amdgcn_readfirstlane(F.tid >> 6);
    int bx = blockIdx.x; asm volatile("" : "+s"(bx)); F.vcu = (bx % 8) * (GRID / 8) + bx / 8; return F; }

__device__ __forceinline__ void tr_item(const float* W, int ldw, int K, const float* kg, const float* ng, float cmul, bf16_t* WT, int blk, int blkstride, int blkoff,
                                        LAS float* scr, int item, int nblk, int lane) {
    const int kb = item / nblk, nb = item % nblk, k0 = 64 * kb, n0 = 64 * nb;
    const int n4 = (lane & 15) * 4, kr = lane >> 4;
    f32x4 gn = (f32x4){cmul, cmul, cmul, cmul}; if (ng) gn = *(const f32x4*)(ng + n0 + n4) * cmul;
    f32x4 v[16]; float gk[16];
#pragma unroll
    for (int i = 0; i < 16; ++i) v[i] = *(const f32x4*)(W + (size_t)(k0 + 4 * i + kr) * ldw + n0 + n4);
#pragma unroll
    for (int i = 0; i < 16; ++i) gk[i] = kg ? kg[k0 + 4 * i + kr] : 1.f;
#pragma unroll
    for (int i = 0; i < 16; ++i) { const f32x4 x = v[i] * gn * gk[i]; LAS float* d = scr + (4 * i + kr) * 65 + n4; d[0] = x[0]; d[1] = x[1]; d[2] = x[2]; d[3] = x[3]; }
    LDS_WAIT(); asm volatile("" ::: "memory");
    const int c = lane & 7;
    const int rbase = (n0 / blk) * blkstride + blkoff + (n0 % blk);
#pragma unroll
    for (int j = 0; j < 8; ++j) { const int n = (lane >> 3) + 8 * j; const LAS float* s = scr + (8 * c) * 65 + n;
        u32x4 o; o.x = cvt_pk_bf16(s[0 * 65], s[1 * 65]); o.y = cvt_pk_bf16(s[2 * 65], s[3 * 65]); o.z = cvt_pk_bf16(s[4 * 65], s[5 * 65]); o.w = cvt_pk_bf16(s[6 * 65], s[7 * 65]);
        *(u32x4*)(WT + (size_t)(rbase + n) * K + k0 + 8 * c) = o; }
    LDS_WAIT(); asm volatile("" ::: "memory");
}
__device__ __forceinline__ void conv_rows(const Frame& F, const float* W, bf16_t* O, int rows, int cols, const float* rg, float cmul) {
    const size_t n8 = (size_t)rows * cols / 8;
    for (size_t i = (size_t)F.vcu * NTHREADS + F.tid; i < n8; i += (size_t)GRID * NTHREADS) { const size_t e = i * 8; const float g = rg[e / cols] * cmul;
        const f32x4 a = *(const f32x4*)(W + e) * g, b = *(const f32x4*)(W + e + 4) * g;
        u32x4 w; w.x = cvt_pk_bf16(a[0], a[1]); w.y = cvt_pk_bf16(a[2], a[3]); w.z = cvt_pk_bf16(b[0], b[1]); w.w = cvt_pk_bf16(b[2], b[3]); *(u32x4*)(O + e) = w; }
}
__device__ __forceinline__ void tr_job(const Frame& F, int& base, const float* W, int ldw, int K, int N, const float* kg, const float* ng, float cmul, bf16_t* WT, int blk, int blkstride, int blkoff) {
    const int NGW = GRID * NWAVES, gw = F.vcu * NWAVES + F.wave;
    LAS float* scr = (LAS float*)(F.lds + F.wave * 16640);
    const int nblk = N / 64, nitems = (K / 64) * nblk;
    int first = (gw - (base % NGW) + NGW) % NGW;
    for (int it = first; it < nitems; it += NGW) tr_item(W, ldw, K, kg, ng, cmul, WT, blk, blkstride, blkoff, scr, it, nblk, F.lane);
    base += nitems;
}

template <bool NORM>
__device__ __forceinline__ void row_to_bf16(const float* src, bf16_t* dstb, float* rinv_out, int lane) {
    f32x4 v[8]; float ss = 0.f;
#pragma unroll
    for (int j = 0; j < 4; ++j) { const f32x4* p = (const f32x4*)(src + j * 512 + lane * 8); v[2 * j] = p[0]; v[2 * j + 1] = p[1]; }
#pragma unroll
    for (int j = 0; j < 8; ++j) ss += (v[j][0] * v[j][0] + v[j][1] * v[j][1]) + (v[j][2] * v[j][2] + v[j][3] * v[j][3]);
    const float rinv = rsqrtf(wave_sum(ss) * (1.f / D) + EPS); const float sc = NORM ? rinv : 1.f;
    if (!NORM && lane == 0) *rinv_out = rinv;
#pragma unroll
    for (int j = 0; j < 4; ++j) {
        const f32x4 a = v[2 * j] * sc, b = v[2 * j + 1] * sc;
        u32x4 w; w.x = cvt_pk_bf16(a[0], a[1]); w.y = cvt_pk_bf16(a[2], a[3]); w.z = cvt_pk_bf16(b[0], b[1]); w.w = cvt_pk_bf16(b[2], b[3]);
        *(u32x4*)(dstb + j * 512 + lane * 8) = w; }
}

template <bool FINAL>
__device__ __forceinline__ void row_pass(const Frame& F, bf16_t* XBp, const bf16_t* HB, const float* ssp, const float* g, float* rinv_out, float* OUT) {
    const int NGW = GRID * NWAVES, gw = F.vcu * NWAVES + F.wave, lane = F.lane;
    f32x4 gv[8];
#pragma unroll
    for (int j = 0; j < 4; ++j) { const f32x4* p = (const f32x4*)(g + j * 512 + lane * 8); gv[2 * j] = p[0]; gv[2 * j + 1] = p[1]; }
    for (int row = gw; row < M; row += NGW) {
        bf16_t* xr = XBp + (size_t)row * D; const bf16_t* hr = HB + (size_t)row * D;
        u32x4 xw[4], hw[4];
#pragma unroll
        for (int j = 0; j < 4; ++j) { xw[j] = *(const u32x4*)(xr + j * 512 + lane * 8); hw[j] = *(const u32x4*)(hr + j * 512 + lane * 8); }
        const float part = lane < 32 ? ssp[(size_t)row * 32 + lane] : 0.f;
        const float rh = rsqrtf(wave_sum(part) * (1.f / D) + EPS);
        float ss = 0.f;
#pragma unroll
        for (int j = 0; j < 4; ++j) {
            const f32x4 x0 = (f32x4){bf_lo(xw[j].x), bf_hi(xw[j].x), bf_lo(xw[j].y), bf_hi(xw[j].y)}, x1 = (f32x4){bf_lo(xw[j].z), bf_hi(xw[j].z), bf_lo(xw[j].w), bf_hi(xw[j].w)};
            const f32x4 h0 = (f32x4){bf_lo(hw[j].x), bf_hi(hw[j].x), bf_lo(hw[j].y), bf_hi(hw[j].y)}, h1 = (f32x4){bf_lo(hw[j].z), bf_hi(hw[j].z), bf_lo(hw[j].w), bf_hi(hw[j].w)};
            const f32x4 a = x0 + h0 * rh * gv[2 * j], b = x1 + h1 * rh * gv[2 * j + 1];
            if (FINAL) { f32x4* p = (f32x4*)(OUT + (size_t)row * D + j * 512 + lane * 8); p[0] = a; p[1] = b; }
            else { ss += (a[0] * a[0] + a[1] * a[1]) + (a[2] * a[2] + a[3] * a[3]) + (b[0] * b[0] + b[1] * b[1]) + (b[2] * b[2] + b[3] * b[3]);
                u32x4 w; w.x = cvt_pk_bf16(a[0], a[1]); w.y = cvt_pk_bf16(a[2], a[3]); w.z = cvt_pk_bf16(b[0], b[1]); w.w = cvt_pk_bf16(b[2], b[3]);
                *(u32x4*)(xr + j * 512 + lane * 8) = w; } }
        if (!FINAL) { const float rinv = rsqrtf(wave_sum(ss) * (1.f / D) + EPS); if (lane == 0) rinv_out[row] = rinv; }
    }
}

__device__ __forceinline__ void ld8(const bf16_t* p, float (&o)[8]) { const u32x4 w = *(const u32x4*)p; o[0] = bf_lo(w.x); o[1] = bf_hi(w.x); o[2] = bf_lo(w.y); o[3] = bf_hi(w.y); o[4] = bf_lo(w.z); o[5] = bf_hi(w.z); o[6] = bf_lo(w.w); o[7] = bf_hi(w.w); }
__device__ __forceinline__ void ld8s(const bf16_t* p, float sc, float (&o)[8]) { ld8(p, o);
#pragma unroll
    for (int e = 0; e < 8; ++e) o[e] *= sc; }
template <int H, int R> __device__ __forceinline__ void pool_item(const bf16_t* base, const float* rb0, int t0, bf16_t* dst) {
    constexpr int NR = R + 2 * H - 1;
    u32x4 rw[NR]; float wt[NR];
#pragma unroll
    for (int j = 0; j < NR; ++j) { const int tt = t0 - H + j, tc = tt < 0 ? 0 : (tt > SEQ - 1 ? SEQ - 1 : tt); rw[j] = *(const u32x4*)(base + (size_t)tc * D); wt[j] = (tt == tc) ? rb0[tc] : 0.f; }
    float s[8];
#pragma unroll
    for (int e = 0; e < 8; ++e) s[e] = 0.f;
#define POOL_ACC(j, sgn) do { const u32x4 q_ = rw[j]; const float w_ = (sgn) * wt[j]; \
        s[0] += bf_lo(q_.x) * w_; s[1] += bf_hi(q_.x) * w_; s[2] += bf_lo(q_.y) * w_; s[3] += bf_hi(q_.y) * w_; s[4] += bf_lo(q_.z) * w_; s[5] += bf_hi(q_.z) * w_; s[6] += bf_lo(q_.w) * w_; s[7] += bf_hi(q_.w) * w_; } while (0)
#pragma unroll
    for (int j = 0; j < 2 * H - 1; ++j) POOL_ACC(j, 1.f);
#pragma unroll
    for (int i = 0; i < R; ++i) { const int t = t0 + i;
        POOL_ACC(i + 2 * H - 1, 1.f);
        const int lo = t - H > 0 ? t - H : 0, hi = t + H < SEQ ? t + H : SEQ; const float ic = 1.f / (float)(hi - lo);
        const u32x4 q = rw[i + H]; const float wc = wt[i + H];
        float o[8]; o[0] = s[0] * ic - bf_lo(q.x) * wc; o[1] = s[1] * ic - bf_hi(q.x) * wc; o[2] = s[2] * ic - bf_lo(q.y) * wc; o[3] = s[3] * ic - bf_hi(q.y) * wc;
        o[4] = s[4] * ic - bf_lo(q.z) * wc; o[5] = s[5] * ic - bf_hi(q.z) * wc; o[6] = s[6] * ic - bf_lo(q.w) * wc; o[7] = s[7] * ic - bf_hi(q.w) * wc;
        u32x4 w; w.x = cvt_pk_bf16(o[0], o[1]); w.y = cvt_pk_bf16(o[2], o[3]); w.z = cvt_pk_bf16(o[4], o[5]); w.w = cvt_pk_bf16(o[6], o[7]);
        *(u32x4*)(dst + (size_t)i * D) = w;
        POOL_ACC(i, -1.f); }
#undef POOL_ACC
}
__device__ __forceinline__ void pool_pre(const Frame& F, const bf16_t* XBp, const float* rinv, bf16_t* DA) {
    const int gt = F.vcu * NTHREADS + F.tid, NT = GRID * NTHREADS;
    int kk = 0;
    for (int it = gt; it < (M / 16) * (D / 8); it += NT, ++kk) {
        const int cc = (it % (D / 8) + 64 * kk) % (D / 8), rb = it / (D / 8);
        const int grp = __builtin_amdgcn_readfirstlane(cc >> 6);
        const int r0 = __builtin_amdgcn_readfirstlane(rb * 16), t0 = r0 % SEQ; const bf16_t* base = XBp + (size_t)(r0 - t0) * D + cc * 8;
        const float* rb0 = rinv + (r0 - t0); bf16_t* dst = DA + (size_t)r0 * D + cc * 8;
        if (grp == 0) pool_item<1, 16>(base, rb0, t0, dst); else if (grp == 1) pool_item<2, 16>(base, rb0, t0, dst); else if (grp == 2) pool_item<4, 16>(base, rb0, t0, dst);
        else { pool_item<8, 8>(base, rb0, t0, dst); pool_item<8, 8>(base, rb0, t0 + 8, dst + (size_t)8 * D); }
    }
}

__device__ __forceinline__ int tswz(int c) { return ((c & 3) ^ ((((c >> 3) ^ (c >> 7)) & 1) | (((c >> 6) & 1) << 1))) | (((c >> 4) & 3) << 2); }
__device__ __forceinline__ void spatial_phase(const Frame& F, const bf16_t* U, const bf16_t* V, const float* vst, const bf16_t* Wsb, const float* bs, const float* lng, const float* lnb, bf16_t* GATED) {
    LAS unsigned char* T = F.lds; LAS f32x2* st = (LAS f32x2*)(F.lds + 65536);
    const int tid = F.tid, lane = F.lane, w = F.wave;
    for (int idx = F.vcu; idx < (M / 128) * 8; idx += GRID) {
        const int chunk = idx >> 3, head = idx & 7; const size_t rowb = (size_t)chunk * 128;
        __syncthreads();
        if (tid < 128) { const f32x4* p = (const f32x4*)(vst + (rowb + tid) * 64); float s = 0.f, q = 0.f;
#pragma unroll
            for (int i = 0; i < 16; ++i) { const f32x4 x = p[i]; s += x[0] + x[2]; q += x[1] + x[3]; }
            const float mu = s * (1.f / DG); const float var = q * (1.f / DG) - mu * mu; st[tid] = (f32x2){mu, rsqrtf(fmaxf(var, 0.f) + EPS)}; }
        __syncthreads();
        {
            const int c8 = (tid & 31) * 8, qg = tid >> 5; float lg[8], lb[8];
#pragma unroll
            for (int e = 0; e < 8; ++e) { lg[e] = lng[head * 256 + c8 + e]; lb[e] = lnb[head * 256 + c8 + e]; }
            float x[8][8];
#pragma unroll
            for (int r = 0; r < 8; ++r) { const int q = qg * 8 + r; float v[8]; ld8(V + (rowb + q) * DG + head * 256 + c8, v); const f32x2 ms = st[q];
#pragma unroll
                for (int e = 0; e < 8; ++e) x[r][e] = (v[e] - ms.x) * ms.y * lg[e] + lb[e]; }
#pragma unroll
            for (int e = 0; e < 8; ++e) { const int c = c8 + e; u32x4 wv; wv.x = cvt_pk_bf16(x[0][e], x[1][e]); wv.y = cvt_pk_bf16(x[2][e], x[3][e]); wv.z = cvt_pk_bf16(x[4][e], x[5][e]); wv.w = cvt_pk_bf16(x[6][e], x[7][e]);
                *(LAS u32x4*)(T + c * 256 + ((qg ^ tswz(c)) << 4)) = wv; }
        }
        bf16x8 wf[4];
#pragma unroll
        for (int ks = 0; ks < 4; ++ks) wf[ks] = *(const bf16x8*)(Wsb + ((size_t)head * 128 + 16 * w + (lane & 15)) * 128 + ks * 32 + (lane >> 4) * 8);
        __syncthreads();
        f32x4 acc[16];
#pragma unroll
        for (int nb = 0; nb < 16; ++nb) acc[nb] = (f32x4){0.f, 0.f, 0.f, 0.f};
        const int s = lane & 15, kq = lane >> 4;
#pragma unroll
        for (int nb = 0; nb < 16; ++nb) { const int c = 64 * (nb >> 2) + 16 * (s >> 2) + 4 * (nb & 3) + (s & 3); const int sw = tswz(c);
#pragma unroll
            for (int ks = 0; ks < 4; ++ks) { const bf16x8 tf = *(const LAS bf16x8*)(T + c * 256 + (((ks * 4 + kq) ^ sw) << 4));
                acc[nb] = __builtin_amdgcn_mfma_f32_16x16x32_bf16(tf, wf[ks], acc[nb], 0, 0, 0); } }
        const int p = 16 * w + (lane & 15), g4 = lane >> 4; const float bias = bs[head * 128 + p];
        const size_t orow = (rowb + p) * DG + head * 256;
#pragma unroll
        for (int a = 0; a < 4; ++a) { float ua[8], ub[8]; ld8(U + orow + 64 * a + 16 * g4, ua); ld8(U + orow + 64 * a + 16 * g4 + 8, ub);
            float o[16];
#pragma unroll
            for (int b = 0; b < 2; ++b)
#pragma unroll
                for (int e = 0; e < 4; ++e) { o[4 * b + e] = ua[4 * b + e] * (acc[4 * a + b][e] + bias); o[8 + 4 * b + e] = ub[4 * b + e] * (acc[4 * a + 2 + b][e] + bias); }
            u32x4 w0, w1; w0.x = cvt_pk_bf16(o[0], o[1]); w0.y = cvt_pk_bf16(o[2], o[3]); w0.z = cvt_pk_bf16(o[4], o[5]); w0.w = cvt_pk_bf16(o[6], o[7]);
            w1.x = cvt_pk_bf16(o[8], o[9]); w1.y = cvt_pk_bf16(o[10], o[11]); w1.z = cvt_pk_bf16(o[12], o[13]); w1.w = cvt_pk_bf16(o[14], o[15]);
            *(u32x4*)(GATED + orow + 64 * a + 16 * g4) = w0; *(u32x4*)(GATED + orow + 64 * a + 16 * g4 + 8) = w1; }
    }
    __syncthreads();
}

__device__ __forceinline__ const __attribute__((address_space(4))) Args* kargs() {
    const __attribute__((address_space(4))) Args* p = (const __attribute__((address_space(4))) Args*)__builtin_amdgcn_kernarg_segment_ptr();
    asm volatile("" : "+s"(p));
    return p;
}
#define KIN(k) (kargs()->in[k])
#define WSP(off) (kargs()->ws + (off))
#define x_prompt KIN(0)
#define x_sample KIN(1)
#define mem_prompt KIN(2)
#define mem_sample KIN(3)
#define norm_gains KIN(4)
#define mem_norm KIN(5)
#define pool_w KIN(6)
#define pool_scale KIN(7)
#define gmlp_w_in KIN(8)
#define gmlp_ln_g KIN(9)
#define gmlp_ln_b KIN(10)
#define gmlp_w_s KIN(11)
#define gmlp_b_s KIN(12)
#define gmlp_w_out KIN(13)
#define attn_wq KIN(14)
#define attn_wk KIN(15)
#define attn_wv KIN(16)
#define attn_wo KIN(17)
#define ffn_w_gate KIN(18)
#define ffn_w_up KIN(19)
#define ffn_w_down KIN(20)
#define X (kargs()->out)
#define WPOOL ((bf16_t*)WSP(WS_WPOOL))
#define WSB ((bf16_t*)WSP(WS_WS))
#define WIN ((bf16_t*)WSP(WS_WIN))
#define WOUT ((bf16_t*)WSP(WS_WOUT))
#define WQ ((bf16_t*)WSP(WS_WQ))
#define WK ((bf16_t*)WSP(WS_WK))
#define WV ((bf16_t*)WSP(WS_WV))
#define WO ((bf16_t*)WSP(WS_WO))
#define WGU ((bf16_t*)WSP(WS_WGU))
#define WDN ((bf16_t*)WSP(WS_WDN))
#define MEMBN ((bf16_t*)WSP(WS_MEMBN))
#define KMAT ((bf16_t*)WSP(WS_KMAT))
#define VT ((bf16_t*)WSP(WS_VT))
#define XB ((bf16_t*)WSP(WS_XB))
#define HB ((bf16_t*)WSP(WS_HB))
#define SSP ((float*)WSP(WS_SSP))
#define VST ((float*)WSP(WS_VST))
#define RSP ((float*)WSP(WS_RSP))
#define RINV ((float*)WSP(WS_RINV))
#define UB ((bf16_t*)WSP(WS_BIG + BIG_U))
#define VB ((bf16_t*)WSP(WS_BIG + BIG_V))
#define DA ((bf16_t*)WSP(WS_BIG + BIG_DA))
#define MTB ((bf16_t*)WSP(WS_BIG + BIG_MT))
#define VWTB ((bf16_t*)WSP(WS_BIG + BIG_VWT))
#define PT ((bf16_t*)WSP(WS_BIG + BIG_PT))
#define HF ((bf16_t*)WSP(WS_BIG + BIG_HF))
#define GATED UB

#define GRID_BAR() do { XcdBarrier _b; _b.bar = (unsigned*)WSP(WS_CTL) + CW_BAR; _b.x = xb_xcc_id(); _b.st = (volatile LAS unsigned*)(lds + MISC_OFF) + 8; xcd_barrier(_b); if (BARX2) xcd_barrier(_b); } while (0)
#define MK_STEP (size_t)BM * D * 2
__global__ void __launch_bounds__(NTHREADS, 2) mega_fwd(Args args) {
    extern __shared__ __attribute__((aligned(16))) unsigned char lds_raw[];
    LAS unsigned char* const lds = (LAS unsigned char*)lds_raw; (void)args;
    if (gridDim.x != GRID) return;
    { volatile LAS unsigned* MISC = (volatile LAS unsigned*)(lds + MISC_OFF); if (threadIdx.x < 32) MISC[threadIdx.x] = 0u; __syncthreads();
      (void)xcd_barrier_post((unsigned*)WSP(WS_CTL) + CW_BAR, MISC + 8); }

    {
        const Frame F = make_frame(lds); const int NGW = GRID * NWAVES, gw = F.vcu * NWAVES + F.wave;
        int base = 0;
        if (PH(0)) REP(0) for (int i = 0; i < DEPTH; ++i) {
            const float* g = norm_gains + (size_t)i * 6 * D;
            conv_rows(F, attn_wq + (size_t)i * D * D, WQ + (size_t)i * D * D, D, D, g + 2 * D, 0.04419417382415922f);
            tr_job(F, base, attn_wk + (size_t)i * D * D, D, D, D, mem_norm + (size_t)i * D, nullptr, 1.f, WK + (size_t)i * D * D, D, D, 0);
            tr_job(F, base, attn_wv + (size_t)i * D * D, D, D, D, mem_norm + (size_t)i * D, nullptr, 1.f, WV + (size_t)i * D * D, D, D, 0);
            tr_job(F, base, attn_wo + (size_t)i * D * D, D, D, D, nullptr, nullptr, 1.f, WO + (size_t)i * D * D, D, D, 0);
            tr_job(F, base, ffn_w_gate + (size_t)i * D * DFF, DFF, D, DFF, g + 4 * D, nullptr, 1.f, WGU + (size_t)i * 2 * DFF * D, 128, 256, 0);
            tr_job(F, base, ffn_w_up + (size_t)i * D * DFF, DFF, D, DFF, g + 4 * D, nullptr, 1.f, WGU + (size_t)i * 2 * DFF * D, 128, 256, 128);
            tr_job(F, base, ffn_w_down + (size_t)i * DFF * D, D, DFF, D, nullptr, nullptr, 1.f, WDN + (size_t)i * D * DFF, D, D, 0);
        }
        if (PH(0)) REP(0) for (int j = 0; j < 2; ++j) {
            const float* g0p = norm_gains + (size_t)(2 * j) * 6 * D;
            const float* g0g = norm_gains + (size_t)(2 * j + 1) * 6 * D;
            for (int gq = 0; gq < 4; ++gq)
                tr_job(F, base, pool_w + ((size_t)j * 4 + gq) * 512 * 512, 512, 512, 512, g0p + gq * 512, pool_scale + (size_t)j * D + gq * 512, 1.f, WPOOL + ((size_t)j * 4 + gq) * 512 * 512, 512, 512, 0);
            tr_job(F, base, gmlp_w_in + (size_t)j * D * 2 * DG, 2 * DG, D, 2 * DG, g0g, nullptr, 1.f, WIN + (size_t)j * 2 * DG * D, 2 * DG, 2 * DG, 0);
            tr_job(F, base, gmlp_w_out + (size_t)j * DG * D, D, DG, D, nullptr, nullptr, 1.f, WOUT + (size_t)j * D * DG, D, D, 0);
        }
        if (PH(1)) REP(1) for (int i = (F.vcu * NTHREADS + F.tid) * 8; i < 2 * 8 * 128 * 128; i += GRID * NTHREADS * 8) { const f32x4 a = *(const f32x4*)(gmlp_w_s + i), b = *(const f32x4*)(gmlp_w_s + i + 4);
            u32x4 w; w.x = cvt_pk_bf16(a[0], a[1]); w.y = cvt_pk_bf16(a[2], a[3]); w.z = cvt_pk_bf16(b[0], b[1]); w.w = cvt_pk_bf16(b[2], b[3]); *(u32x4*)(WSB + i) = w; }
        if (PH(1)) REP(1) for (int r = gw; r < MM; r += NGW) { const float* src = r < NPROMPT_MEM ? mem_prompt + (size_t)r * D : mem_sample + (size_t)(r - NPROMPT_MEM) * D; row_to_bf16<true>(src, MEMBN + (size_t)r * D, nullptr, F.lane); }
        if (PH(1)) REP(1) for (int r = gw; r < M; r += NGW) { const float* src = r < NPROMPT_ROWS ? x_prompt + (size_t)r * D : x_sample + (size_t)(r - NPROMPT_ROWS) * D; row_to_bf16<false>(src, XB + (size_t)r * D, RINV + r, F.lane); }
    }
    GRID_BAR();
    if (PH(2)) REP(2) {
        MapKV mp; mp.A = (const char*)MEMBN; mp.B = (const char*)WK;
        EpiPlain<false> E{KMAT, D, nullptr, nullptr};
        gemm_phase<EpiPlain<false>, MapKV, MK_ALIGN>(lds, mp, E, D, D, D);
    }
    GRID_BAR();

    for (int layer = 0; layer < DEPTH; ++layer) {
        if ((layer & 1) == 0) {
            if (PH(3)) REP(3) pool_pre(make_frame(lds), XB, RINV, DA);
            GRID_BAR();
            if (PH(4)) REP(4) {
#if PORDER
                MapPoolP mp;
#else
                MapPool mp;
#endif
                mp.A = (const char*)DA; mp.B = (const char*)(WPOOL + (size_t)(layer >> 1) * 4 * 512 * 512);
                EpiPlain<true> E{HB, D, SSP, nullptr};
                gemm_phase<EpiPlain<true>, decltype(mp), MK_ALIGN>(lds, mp, E, 512, D, 512); }
            GRID_BAR();
        } else {
            if (PH(5)) REP(5) {   MapReg<M / BM, (2 * DG) / BM, BM> mp; mp.A = (const char*)XB; mp.B = (const char*)(WIN + (size_t)(layer >> 1) * 2 * DG * D); mp.astep = MK_STEP; mp.bstep = MK_STEP;
                EpiGeluUV E{UB, VB, VST, RINV};
                gemm_phase<EpiGeluUV, MapReg<M / BM, (2 * DG) / BM, BM>, MK_ALIGN>(lds, mp, E, D, D, D); }
            GRID_BAR();
            if (PH(6)) REP(6) { const int j = layer >> 1; spatial_phase(make_frame(lds), UB, VB, VST, WSB + (size_t)j * 8 * 128 * 128, gmlp_b_s + (size_t)j * 8 * 128, gmlp_ln_g + (size_t)j * DG, gmlp_ln_b + (size_t)j * DG, GATED); }
            GRID_BAR();
            if (PH(7)) REP(7) {
#if PORDER
            MapRegP mp;
#else
            MapReg<M / BM, D / BM, BM> mp;
#endif
            mp.A = (const char*)GATED; mp.B = (const char*)(WOUT + (size_t)(layer >> 1) * D * DG); mp.astep = MK_STEP; mp.bstep = MK_STEP;
                EpiPlain<true> E{HB, D, SSP, nullptr};
                gemm_phase<EpiPlain<true>, decltype(mp), MK_ALIGN>(lds, mp, E, DG, DG, DG); }
            GRID_BAR();
        }
        if (PH(8)) row_pass<false>(make_frame(lds), XB, HB, SSP, norm_gains + ((size_t)layer * 6 + 1) * D, RINV, nullptr);
        if (PH(9)) REP(9) {   MapMT mp; mp.Kl = (const char*)(KMAT + (size_t)layer * MM * D); mp.Wq = (const char*)(WQ + (size_t)layer * D * D);
            EpiMTVWT E{MTB, VWTB};
            gemm_phase<EpiMTVWT, MapMT, MK_ALIGN>(lds, mp, E, HD, D, D); }
        GRID_BAR();
        if (PH(10)) REP(10) {   MapS2 mp; mp.Xp = (const char*)XB; mp.MTp = (const char*)MTB;
            EpiSoftmax2 E{PT, RINV};
            gemm_phase<EpiSoftmax2, MapS2, true>(lds, mp, E, D, D, D); }
        if (PH(9)) REP(9) {   MapVWT2 mp; mp.Vl = (const char*)(KMAT + (size_t)(4 + layer) * MM * D); mp.Wo = (const char*)(WO + (size_t)layer * D * D);
            EpiMTVWT E{MTB, VWTB};
            gemm_phase<EpiMTVWT, MapVWT2, MK_ALIGN>(lds, mp, E, HD, D, D); }
        GRID_BAR();
        if (PH(11)) REP(11) {   MapPVO mp; mp.P = (const char*)PT; mp.VW = (const char*)VWTB;
            EpiPlain<true> E{HB, D, SSP, nullptr};
            gemm_phase<EpiPlain<true>, MapPVO, MK_ALIGN>(lds, mp, E, 1024, 1024, 1024); }
        GRID_BAR();
        if (PH(8)) row_pass<false>(make_frame(lds), XB, HB, SSP, norm_gains + ((size_t)layer * 6 + 3) * D, RINV, nullptr);
        GRID_BAR();
        if (PH(13)) REP(13) {   MapReg<M / BM, (2 * DFF) / BM, 128> mp; mp.A = (const char*)XB; mp.B = (const char*)(WGU + (size_t)layer * 2 * DFF * D); mp.astep = MK_STEP; mp.bstep = MK_STEP;
            EpiSwiglu E{HF, RINV};
            gemm_phase<EpiSwiglu, MapReg<M / BM, (2 * DFF) / BM, 128>, MK_ALIGN>(lds, mp, E, D, D, D); }
        GRID_BAR();
        if (PH(14)) REP(14) {
#if PORDER
            MapRegP mp;
#else
            MapReg<M / BM, D / BM, BM> mp;
#endif
            mp.A = (const char*)HF; mp.B = (const char*)(WDN + (size_t)layer * D * DFF); mp.astep = (size_t)BM * DFF * 2; mp.bstep = (size_t)BM * DFF * 2;
            EpiPlain<true> E{HB, D, SSP, nullptr};
            gemm_phase<EpiPlain<true>, decltype(mp), MK_ALIGN>(lds, mp, E, DFF, DFF, DFF); }
        GRID_BAR();
        if (layer < DEPTH - 1) { if (PH(8)) row_pass<false>(make_frame(lds), XB, HB, SSP, norm_gains + ((size_t)layer * 6 + 5) * D, RINV, nullptr); GRID_BAR(); }
        else if (PH(15)) row_pass<true>(make_frame(lds), XB, HB, SSP, norm_gains + ((size_t)layer * 6 + 5) * D, nullptr, X);
    }
}
}

static void mk_launch(void* const* d_in, void* d_out, void* d_ws, size_t ws_size, hipStream_t stream) {
    static int ok = 0;
    if (ok == 0) {
        ok = -1;
        if (ws_size < mk::WS_END) { fprintf(stderr, "kernel_launch: workspace too small (%zu < %zu)\n", ws_size, (size_t)mk::WS_END); return; }
        if (hipFuncSetAttribute((const void*)mk::mega_fwd, hipFuncAttributeMaxDynamicSharedMemorySize, mk::LDS_BYTES) != hipSuccess) { fprintf(stderr, "kernel_launch: hipFuncSetAttribute failed\n"); return; }
        int dev = 0, cus = 0, per_cu = 0;
        (void)hipGetDevice(&dev); (void)hipDeviceGetAttribute(&cus, hipDeviceAttributeMultiprocessorCount, dev);
        (void)hipOccupancyMaxActiveBlocksPerMultiprocessor(&per_cu, (const void*)mk::mega_fwd, mk::NTHREADS, mk::LDS_BYTES);
        (void)hipGetLastError();
        if (cus < mk::GRID || per_cu < 1) { fprintf(stderr, "kernel_launch: needs %d CUs with one resident block each (cus %d, per_cu %d)\n", mk::GRID, cus, per_cu); return; }
        ok = 1;
    }
    if (ok < 0) return;
    (void)hipMemsetAsync((char*)d_ws + mk::WS_CTL, 0, mk::CTL_BYTES, stream);
    mk::Args a{};
    for (int i = 0; i < 21; ++i) a.in[i] = (const float*)d_in[i];
    a.out = (float*)d_out; a.ws = (unsigned char*)d_ws;
    hipLaunchKernelGGL(mk::mega_fwd, dim3(mk::GRID), dim3(mk::NTHREADS), mk::LDS_BYTES, stream, a);
}

extern "C" void kernel_launch(void* const* d_in, const int* in_sizes, int n_in, void* d_out, int out_size, void* d_ws, size_t ws_size, hipStream_t stream) {
    (void)in_sizes; (void)n_in; (void)out_size;
    mk_launch(d_in, d_out, d_ws, ws_size, stream);
}
```

```cpp
#include <hip/hip_runtime.h>
#include <cstdio>
#include <cstdint>

namespace mk {
#define LAS __attribute__((address_space(3)))
#define GAS __attribute__((address_space(1)))
typedef unsigned short bf16_t;
typedef short bf16x8 __attribute__((ext_vector_type(8)));
typedef float f32x4 __attribute__((ext_vector_type(4)));
typedef float f32x2 __attribute__((ext_vector_type(2)));
typedef unsigned u32x4 __attribute__((ext_vector_type(4)));
typedef unsigned u32x2 __attribute__((ext_vector_type(2)));

constexpr int D = 2048, SEQ = 2048, NB = 12, M = NB * SEQ, DEPTH = 4, NMEM = 256, MM = NB * NMEM, DFF = 5632, NH = 4, HD = 512, DG = 2048;
constexpr int NPROMPT_ROWS = 4 * SEQ, NPROMPT_MEM = 4 * NMEM;
constexpr float EPS = 1e-6f;
constexpr int NWAVES = 8, NTHREADS = 512, GRID = 256;
#ifndef PHASES
#define PHASES 0xFFFFF
#endif
#define PH(b) ((PHASES >> (b)) & 1)
#ifndef MK_ALIGN
#define MK_ALIGN false
#endif
#ifndef EPI2
#define EPI2 0
#endif
#ifndef PORDER
#define PORDER 0
#endif
#ifndef STAG
#define STAG 0
#endif
#ifndef NSTAG
#define NSTAG 4
#endif
#ifndef EPI_NT
#define EPI_NT 0
#endif
#if EPI_NT
#define EPI_STORE(p, v) __builtin_nontemporal_store((v), (p))
#else
#define EPI_STORE(p, v) (*(p) = (v))
#endif
#ifndef MK_SP2
#define MK_SP2 1
#endif
#ifndef BARX2
#define BARX2 0
#endif
#ifndef ROWPROBE
#define ROWPROBE 0
#endif
#ifndef REPEAT
#define REPEAT 0
#endif
#define REP(b) for (int _r = 0; _r < 1 + ((REPEAT >> (b)) & 1); ++_r)

constexpr size_t MiB = 1u << 20;
constexpr size_t WS_CTL = 0, CTL_BYTES = 1 * MiB;
constexpr size_t WS_WPOOL = 1 * MiB;
constexpr size_t WS_WS = WS_WPOOL + 4 * MiB;
constexpr size_t WS_WIN = WS_WS + 1 * MiB;
constexpr size_t WS_WOUT = WS_WIN + 32 * MiB;
constexpr size_t WS_WQ = WS_WOUT + 16 * MiB;
constexpr size_t WS_WK = WS_WQ + 32 * MiB;
constexpr size_t WS_WV = WS_WK + 32 * MiB;
constexpr size_t WS_WO = WS_WV + 32 * MiB;
constexpr size_t WS_WGU = WS_WO + 32 * MiB;
constexpr size_t WS_WDN = WS_WGU + 176 * MiB;
constexpr size_t WS_MEMBN = WS_WDN + 88 * MiB;
constexpr size_t WS_KMAT = WS_MEMBN + 12 * MiB;
constexpr size_t WS_VT = WS_KMAT + 48 * MiB;
constexpr size_t WS_XB = WS_VT + 48 * MiB;
constexpr size_t WS_HB = WS_XB + 96 * MiB;
constexpr size_t WS_BIG = WS_HB + 96 * MiB;
constexpr size_t WS_SSP = WS_BIG + 264 * MiB;
constexpr size_t WS_VST = WS_SSP + 3 * MiB;
constexpr size_t WS_RSP = WS_VST + 6 * MiB;
constexpr size_t WS_RINV = WS_RSP + 2 * MiB;
constexpr size_t WS_END = WS_RINV + 1 * MiB;
constexpr size_t BIG_U = 0, BIG_V = 96 * MiB, BIG_DA = 0, BIG_MT = 0, BIG_VWT = 48 * MiB, BIG_PT = 192 * MiB, BIG_HF = 0;
constexpr int CW_BAR = 4096;
constexpr int CW_GUQ = 16384;

constexpr int RING_BYTES = 131072, RED_OFF = RING_BYTES, RED2_OFF = RED_OFF + 4096, RDMA_OFF = RED_OFF + 8192, MISC_OFF = RED_OFF + 12288, LDS_BYTES = 147456;

#define LDS_WAIT() asm volatile("s_waitcnt lgkmcnt(0)" ::: "memory")
#define VM_WAIT() asm volatile("s_waitcnt vmcnt(0)" ::: "memory")

#define XB_TMO      128
#define XB_XCNT(j)  (256  + 64 * (j))
#define XB_XSUB(j)  (1280 + 64 * (j))
#define XB_XGEN(j)  (2304 + 64 * (j))
#define XB_TOP      3328
#define XB_TOPGEN   3392
#define XCD_BAR_WORDS 3456
#define XB_SPIN_CAP (1u << 18)
__device__ __forceinline__ unsigned xb_ld(unsigned* p)              { return __hip_atomic_load(p, __ATOMIC_RELAXED, __HIP_MEMORY_SCOPE_AGENT); }
__device__ __forceinline__ unsigned xb_add(unsigned* p, unsigned v) { return __hip_atomic_fetch_add(p, v, __ATOMIC_RELAXED, __HIP_MEMORY_SCOPE_AGENT); }
__device__ __forceinline__ unsigned xb_xcc_id() { return (unsigned)__builtin_amdgcn_s_getreg((3 << 11) | 20) & 0xFu; }
#define XB_SPIN(cond, bar) do { unsigned _sp = 0; while (cond) { __builtin_amdgcn_s_sleep(1); \
    if ((++_sp & 255u) == 0u) { if (xb_ld(&(bar)[XB_TMO])) break; if (_sp > XB_SPIN_CAP) { atomicAdd(&(bar)[XB_TMO], 1u); break; } } } } while (0)
struct XcdBarrier { unsigned* bar; unsigned x; volatile LAS unsigned* st; };
__device__ __forceinline__ XcdBarrier xcd_barrier_post(unsigned* bar, volatile LAS unsigned* st) {
    XcdBarrier b; b.bar = bar; b.x = xb_xcc_id(); b.st = st;
    if (threadIdx.x == 0) (void)xb_add(&bar[XB_XCNT(b.x)], 1u);
    return b;
}
__device__ __forceinline__ void xcd_barrier_complete(unsigned* bar, unsigned x, unsigned& nloc, unsigned& nx) {
    const unsigned G = gridDim.x * gridDim.y * gridDim.z;
    unsigned sum, cnt, mine, sp = 0u;
    for (;;) {
        sum = 0u; cnt = 0u; mine = 0u;
#pragma unroll
        for (unsigned j = 0; j < 16; ++j) { const unsigned c = xb_ld(&bar[XB_XCNT(j)]); sum += c; cnt += (c > 0u) ? 1u : 0u; mine = (j == x) ? c : mine; }
        if (sum == G) break;
        __builtin_amdgcn_s_sleep(1);
        if ((++sp & 255u) == 0u) { if (xb_ld(&bar[XB_TMO])) break; if (sp > XB_SPIN_CAP) { atomicAdd(&bar[XB_TMO], 1u); break; } }
    }
    nloc = mine > 0u ? mine : 1u; nx = cnt > 0u ? cnt : 1u;
}
__device__ __forceinline__ void xcd_barrier(const XcdBarrier& b) {
    asm volatile("s_waitcnt vmcnt(0)" ::: "memory");
    __syncthreads();
    if (threadIdx.x == 0) {
        unsigned* bar = b.bar;
        __builtin_amdgcn_s_waitcnt(0);
        unsigned nloc = b.st[0], nx = b.st[1];
        if (nloc == 0u) { xcd_barrier_complete(bar, b.x, nloc, nx); b.st[0] = nloc; b.st[1] = nx; }
        const unsigned old = xb_add(&bar[XB_XSUB(b.x)], 1u);
        const unsigned gen = old / nloc;
        if (old + 1u == (gen + 1u) * nloc) {
            __builtin_amdgcn_fence(__ATOMIC_RELEASE, "agent");
            asm volatile("s_waitcnt vmcnt(0)" ::: "memory");
            const unsigned og = xb_add(&bar[XB_TOP], 1u);
            const unsigned tg = og / nx;
            if (og + 1u == (tg + 1u) * nx) xb_add(&bar[XB_TOPGEN], 1u);
            else XB_SPIN(xb_ld(&bar[XB_TOPGEN]) == tg, bar);
            __builtin_amdgcn_fence(__ATOMIC_ACQUIRE, "agent");
            xb_add(&bar[XB_XGEN(b.x)], 1u);
            asm volatile("s_waitcnt vmcnt(0)" ::: "memory");
        } else {
            XB_SPIN(xb_ld(&bar[XB_XGEN(b.x)]) == gen, bar);
            __builtin_amdgcn_fence(__ATOMIC_ACQUIRE, "agent");
            asm volatile("s_waitcnt vmcnt(0)" ::: "memory");
        }
    }
    __syncthreads();
}

__device__ __forceinline__ unsigned cvt_pk_bf16(float lo, float hi) { unsigned r; asm volatile("v_cvt_pk_bf16_f32 %0, %1, %2" : "=v"(r) : "v"(lo), "v"(hi)); return r; }
__device__ __forceinline__ float bf_lo(unsigned w) { return __uint_as_float(w << 16); }
__device__ __forceinline__ float bf_hi(unsigned w) { return __uint_as_float(w & 0xffff0000u); }
__device__ __forceinline__ float wave_sum(float v) {
#pragma unroll
    for (int o = 1; o < 64; o <<= 1) v += __shfl_xor(v, o);
    return v;
}
__device__ __forceinline__ float fast_exp(float x) { return __builtin_amdgcn_exp2f(x * 1.4426950408889634f); }
__device__ __forceinline__ float gelu_tanh_f(float x) {
    const float u = x * (1.5957691216057308f + 0.07135481282803448f * x * x);
    return x * __builtin_amdgcn_rcpf(1.f + fast_exp(-u));
}
__device__ __forceinline__ float silu_f(float x) { return x * __builtin_amdgcn_rcpf(1.f + fast_exp(-x)); }

constexpr int BM = 256, BK = 64, HALF = 128, HTB = HALF * BK * 2, NXCD = 8, WGM = 8;
__device__ __forceinline__ int lds_byte(int r, int c) { const int st = (r >> 4) * 2 + (c >> 5), rr = r & 15, cc = c & 31, ob = rr * 64 + cc * 2; return st * 1024 + (ob ^ (((ob >> 9) & 1) << 5)); }
__device__ __forceinline__ void stage_rc(int b, int& R, int& C) { const int st = b / 1024, sb = b % 1024, swz = sb ^ (((sb >> 9) & 1) << 5); R = (st >> 1) * 16 + swz / 64; C = (st & 1) * 32 + (swz % 64) / 2; }
__device__ __forceinline__ int perm32(int rho) { const int n = rho >> 4, i = rho & 15; return 8 * (i >> 2) + 4 * n + (i & 3); }

struct GU { const char* A; const char* B; int r0, c0, aux; };
struct Tile { int pm, pn; };
template <int nM, int nN> struct Order {
    static constexpr int nwg = nM * nN, G = GRID;
    __device__ __forceinline__ bool tile(int i, Tile& t) const {
        int c = (int)blockIdx.x; asm volatile("" : "+s"(c));
        const long L = (long)i * G + c; if (L >= nwg) return false;
        int wgid = (int)L; { const int q = nwg / NXCD, r = nwg % NXCD, xcd = wgid % NXCD, off = wgid / NXCD; wgid = (xcd < r ? xcd * (q + 1) : r * (q + 1) + (xcd - r) * q) + off; }
        tile_wg(wgid, t); return true;
    }
    __device__ __forceinline__ void tile_wg(int wgid, Tile& t) const {
        const int nig = WGM * nN, gid = wgid / nig, fm = gid * WGM, gsz = (nM - fm) < WGM ? (nM - fm) : WGM;
        t.pm = fm + ((wgid % nig) % gsz); t.pn = (wgid % nig) / gsz;
    }
};
template <class Epi, class Map, bool ALIGN_EPI>
__device__ __forceinline__ void gemm_phase(LAS unsigned char* lds, const Map& S, const Epi& E, const int K, const int lda, const int ldb) {
    int tid_ = threadIdx.x; asm volatile("" : "+v"(tid_));
    const int tid = tid_, wid = __builtin_amdgcn_readfirstlane(tid >> 6), lane = tid & 63, wr = wid >> 2, wc = wid & 3, fr = lane & 15, fq = lane >> 4;
    const int nt = K / BK;
    unsigned voffA[2], voffB[2];
#pragma unroll
    for (int i = 0; i < 2; ++i) { int R, C; stage_rc(tid * 16 + i * 8192, R, C); const int Rb = (R & ~31) + perm32(R & 31);
        voffA[i] = (unsigned)(R * lda + C) * 2u; voffB[i] = (unsigned)(Rb * ldb + C) * 2u; }
    const size_t kstep = (size_t)(BK * 2);
    const size_t hstepA = (size_t)HALF * lda * 2, hstepB = (size_t)HALF * ldb * 2;
    const unsigned ldsw = (unsigned)wid * 1024u;
    const int aoff = lds_byte(wr * 64 + fr, fq * 8), boff = lds_byte(wc * 32 + fr, fq * 8);
#define PG8_SA(b, h) (((b) * 2 + (h)) * HTB)
#define PG8_SB(b, h) ((4 + (b) * 2 + (h)) * HTB)
#define PG8_STAGE(bufoff, gbase, voff) do { _Pragma("unroll") for (int _i = 0; _i < 2; ++_i) \
        __builtin_amdgcn_global_load_lds((const unsigned*)((const char*)(gbase) + (voff)[_i]), (LAS unsigned*)(lds + (bufoff) + ldsw + _i * 8192), 16, 0, 0); } while (0)
#define PG8_LDA(dst, b, h) do { _Pragma("unroll") for (int m = 0; m < 4; ++m) _Pragma("unroll") for (int k = 0; k < 2; ++k) dst[m][k] = *(const LAS bf16x8*)(lds + PG8_SA(b, h) + aoff + m * 2048 + k * 1024); } while (0)
#define PG8_LDB(dst, b, h) do { _Pragma("unroll") for (int n = 0; n < 2; ++n) _Pragma("unroll") for (int k = 0; k < 2; ++k) dst[n][k] = *(const LAS bf16x8*)(lds + PG8_SB(b, h) + boff + n * 2048 + k * 1024); } while (0)
#define PG8_MMA(ai, bj, At, Bt) do { __builtin_amdgcn_s_setprio(1); _Pragma("unroll") for (int m = 0; m < 4; ++m) _Pragma("unroll") for (int n = 0; n < 2; ++n) _Pragma("unroll") for (int k = 0; k < 2; ++k) \
        acc[ai][bj][m][n] = __builtin_amdgcn_mfma_f32_16x16x32_bf16(Bt[n][k], At[m][k], acc[ai][bj][m][n], 0, 0, 0); __builtin_amdgcn_s_setprio(0); } while (0)
#define PG8_WAIT_V(n) asm volatile("s_waitcnt vmcnt(" #n ")" ::: "memory")
#define PG8_WAIT_L(n) asm volatile("s_waitcnt lgkmcnt(" #n ")" ::: "memory")
#define PG8_BAR __builtin_amdgcn_s_barrier()
#define PG8_SCHED __builtin_amdgcn_sched_barrier(0)
    GU cur, nxt; int ui = 0;
    if (!S.next(0, cur)) return;
    if (STAG > 0) {
        int bx = (int)blockIdx.x; asm volatile("" : "+s"(bx)); const unsigned long long dl = (unsigned long long)(((bx >> 3) % NSTAG) * STAG);
        const unsigned long long t0 = __builtin_amdgcn_s_memrealtime(); while (__builtin_amdgcn_s_memrealtime() - t0 < dl) __builtin_amdgcn_s_sleep(2); }
    f32x4 acc[2][2][4][2];
#pragma unroll
    for (int a = 0; a < 2; ++a)
#pragma unroll
        for (int b = 0; b < 2; ++b)
#pragma unroll
            for (int m = 0; m < 4; ++m)
#pragma unroll
                for (int n = 0; n < 2; ++n) acc[a][b][m][n] = (f32x4){0.f, 0.f, 0.f, 0.f};
    bf16x8 At[4][2], B0[2][2], B1[2][2];
    const char* cA = cur.A; const char* cB = cur.B;
    E.prefetch(cur, wr, wc, lane, lds);
#if MK_SP2
    PG8_STAGE(PG8_SB(0, 0), cB, voffB); PG8_STAGE(PG8_SB(0, 1), cB + hstepB, voffB); PG8_STAGE(PG8_SA(0, 0), cA, voffA); PG8_STAGE(PG8_SA(0, 1), cA + hstepA, voffA);
    if (wr == 1) PG8_BAR;
    PG8_WAIT_V(2); PG8_BAR;
#else
    PG8_STAGE(PG8_SB(0, 0), cB, voffB); PG8_STAGE(PG8_SA(0, 0), cA, voffA); PG8_STAGE(PG8_SB(0, 1), cB + hstepB, voffB); PG8_STAGE(PG8_SA(0, 1), cA + hstepA, voffA);
    if (wr == 1) PG8_BAR;
    PG8_WAIT_V(4); PG8_BAR;
#endif
    PG8_STAGE(PG8_SB(1, 0), cB + kstep, voffB); PG8_STAGE(PG8_SA(1, 0), cA + kstep, voffA); PG8_STAGE(PG8_SB(1, 1), cB + hstepB + kstep, voffB);
    PG8_WAIT_V(6); PG8_BAR;
    for (;;) {
        const bool has_next = S.next(ui + 1, nxt);
        const char* nA = has_next ? nxt.A : cA; const char* nB = has_next ? nxt.B : cB;
        for (int t = 0; t < nt; t += 2) {
            const bool last = (t == nt - 2);
            const char* a1 = cA + (size_t)(t + 1) * kstep;
            const char* a2 = last ? nA : cA + (size_t)(t + 2) * kstep; const char* b2 = last ? nB : cB + (size_t)(t + 2) * kstep;
            const char* a3 = a2 + kstep; const char* b3 = b2 + kstep;
#if MK_SP2
            PG8_LDB(B0, 0, 0); PG8_LDB(B1, 0, 1); PG8_SCHED; PG8_LDA(At, 0, 0); PG8_STAGE(PG8_SA(1, 1), a1 + hstepA, voffA);
            PG8_WAIT_V(8); PG8_WAIT_L(0); PG8_BAR; PG8_MMA(0, 0, At, B0); PG8_MMA(0, 1, At, B1); PG8_BAR; PG8_SCHED;
            PG8_LDA(At, 0, 1); PG8_STAGE(PG8_SB(0, 0), b2, voffB); PG8_STAGE(PG8_SB(0, 1), b2 + hstepB, voffB); PG8_STAGE(PG8_SA(0, 0), a2, voffA);
            PG8_WAIT_V(8); PG8_WAIT_L(0); PG8_BAR; PG8_MMA(1, 0, At, B0); PG8_MMA(1, 1, At, B1); PG8_BAR; PG8_SCHED;
            PG8_LDB(B0, 1, 0); PG8_LDB(B1, 1, 1); PG8_SCHED; PG8_LDA(At, 1, 0); PG8_STAGE(PG8_SA(0, 1), a2 + hstepA, voffA);
            PG8_WAIT_V(8); PG8_WAIT_L(0); PG8_BAR; PG8_MMA(0, 0, At, B0); PG8_MMA(0, 1, At, B1); PG8_BAR; PG8_SCHED;
            PG8_LDA(At, 1, 1); PG8_STAGE(PG8_SB(1, 0), b3, voffB); PG8_STAGE(PG8_SB(1, 1), b3 + hstepB, voffB); PG8_STAGE(PG8_SA(1, 0), a3, voffA);
            PG8_WAIT_V(8); PG8_WAIT_L(0); PG8_BAR; PG8_MMA(1, 0, At, B0); PG8_MMA(1, 1, At, B1); PG8_BAR; PG8_SCHED;
        #else
            PG8_LDB(B0, 0, 0); PG8_SCHED; PG8_LDA(At, 0, 0); PG8_STAGE(PG8_SA(1, 1), a1 + hstepA, voffA);
            PG8_WAIT_L(8); PG8_BAR; PG8_WAIT_L(0); PG8_MMA(0, 0, At, B0); PG8_BAR; PG8_SCHED;
            PG8_LDB(B1, 0, 1); PG8_STAGE(PG8_SB(0, 0), b2, voffB);
            PG8_BAR; PG8_WAIT_L(0); PG8_MMA(0, 1, At, B1); PG8_BAR;
            PG8_LDA(At, 0, 1); PG8_STAGE(PG8_SA(0, 0), a2, voffA);
            PG8_BAR; PG8_WAIT_L(0); PG8_MMA(1, 0, At, B0); PG8_BAR; PG8_SCHED;
            PG8_STAGE(PG8_SB(0, 1), b2 + hstepB, voffB);
            PG8_WAIT_V(6); PG8_BAR; PG8_MMA(1, 1, At, B1); PG8_BAR;
            PG8_LDB(B0, 1, 0); PG8_SCHED; PG8_LDA(At, 1, 0); PG8_STAGE(PG8_SA(0, 1), a2 + hstepA, voffA);
            PG8_WAIT_L(8); PG8_BAR; PG8_WAIT_L(0); PG8_MMA(0, 0, At, B0); PG8_BAR; PG8_SCHED;
            PG8_LDB(B1, 1, 1); PG8_STAGE(PG8_SB(1, 0), b3, voffB);
            PG8_BAR; PG8_WAIT_L(0); PG8_MMA(0, 1, At, B1); PG8_BAR;
            PG8_LDA(At, 1, 1); PG8_STAGE(PG8_SA(1, 0), a3, voffA);
            PG8_BAR; PG8_WAIT_L(0); PG8_MMA(1, 0, At, B0); PG8_BAR; PG8_SCHED;
            PG8_STAGE(PG8_SB(1, 1), b3 + hstepB, voffB);
            PG8_WAIT_V(6); PG8_BAR; PG8_MMA(1, 1, At, B1); PG8_BAR;
#endif
        }
        if constexpr (ALIGN_EPI) { if (wr == 0) PG8_BAR; }
        E(acc, cur, wr, wc, fr, fq, lds);
        if (EPI2) E(acc, cur, wr, wc, fr, fq, lds);
        if (!has_next) break;
#pragma unroll
        for (int a = 0; a < 2; ++a)
#pragma unroll
            for (int b = 0; b < 2; ++b)
#pragma unroll
                for (int m = 0; m < 4; ++m)
#pragma unroll
                    for (int n = 0; n < 2; ++n) acc[a][b][m][n] = (f32x4){0.f, 0.f, 0.f, 0.f};
        cur = nxt; cA = nA; cB = nB; ++ui;
        E.prefetch(cur, wr, wc, lane, lds);
        if constexpr (ALIGN_EPI) { if (wr == 1) PG8_BAR; }
    }
    PG8_WAIT_V(0);
    if constexpr (!ALIGN_EPI) { if (wr == 0) PG8_BAR; }
    PG8_BAR;
#undef PG8_SA
#undef PG8_SB
#undef PG8_STAGE
#undef PG8_LDA
#undef PG8_LDB
#undef PG8_MMA
#undef PG8_WAIT_V
#undef PG8_WAIT_L
#undef PG8_BAR
#undef PG8_SCHED
}

template <int nM, int nN, int c0mul> struct MapReg {
    Order<nM, nN> o; const char* A; const char* B; size_t astep, bstep;
    __device__ __forceinline__ bool next(int i, GU& u) const { Tile t; if (!o.tile(i, t)) return false;
        u.A = A + (size_t)t.pm * astep; u.B = B + (size_t)t.pn * bstep; u.r0 = t.pm * BM; u.c0 = t.pn * c0mul; u.aux = t.pn; return true; }
};
struct MapPool {
    Order<M / BM, D / BM> o; const char* A; const char* B;
    __device__ __forceinline__ bool next(int i, GU& u) const { Tile t; if (!o.tile(i, t)) return false;
        u.A = A + ((size_t)t.pm * BM * D + (size_t)(t.pn >> 1) * 512) * 2; u.B = B + (size_t)t.pn * BM * 512 * 2; u.r0 = t.pm * BM; u.c0 = t.pn * BM; u.aux = t.pn; return true; }
};
struct MapGUdyn { Order<M / BM, (2 * DFF) / BM> o; const char* A; const char* B; unsigned* ctr; LAS unsigned char* lds;
    __device__ __forceinline__ bool next(int i, GU& u) const { Tile t;
        if (i < 16) { if (!o.tile(i, t)) return false; }
        else {
            int tz = threadIdx.x; asm volatile("" : "+v"(tz)); const int wid = __builtin_amdgcn_readfirstlane(tz >> 6);
            volatile LAS unsigned* bw = (volatile LAS unsigned*)(lds + MISC_OFF) + 11;
            if (wid == 0) { unsigned tk = 0u; if ((tz & 63) == 0) tk = __hip_atomic_fetch_add(ctr, 1u, __ATOMIC_RELAXED, __HIP_MEMORY_SCOPE_AGENT);
                tk = (unsigned)__builtin_amdgcn_readfirstlane((int)tk); if ((tz & 63) == 0) *bw = tk; asm volatile("s_waitcnt lgkmcnt(0)" ::: "memory"); }
            asm volatile("" ::: "memory"); __builtin_amdgcn_s_barrier(); asm volatile("" ::: "memory");
            const unsigned tk = (unsigned)__builtin_amdgcn_readfirstlane((int)*bw);
            if (tk >= 128u) return false;
            o.tile_wg((int)(tk >> 4) * (o.nwg / NXCD) + (o.nwg / NXCD - 16) + (int)(tk & 15u), t);
        }
        u.A = A + (size_t)t.pm * BM * D * 2; u.B = B + (size_t)t.pn * BM * D * 2; u.r0 = t.pm * BM; u.c0 = t.pn * 128; u.aux = t.pn; return true; }
};
struct MapKV { Order<MM / BM, 64> o; const char* A; const char* B;
    __device__ __forceinline__ bool next(int i, GU& u) const { Tile t; if (!o.tile(i, t)) return false;
        u.A = A + (size_t)t.pm * BM * D * 2; u.B = B + (size_t)t.pn * BM * D * 2; u.r0 = (t.pn >> 3) * MM + t.pm * BM; u.c0 = (t.pn & 7) * BM; u.aux = 0; return true; }
};
struct MapMT { Order<48, 8> o; const char* Kl; const char* Wq;
    __device__ __forceinline__ bool next(int i, GU& u) const { Tile t; if (!o.tile(i, t)) return false;
        const int bh = t.pm, b = bh >> 2, h = bh & 3;
        u.A = Kl + ((size_t)b * NMEM * D + (size_t)h * HD) * 2; u.B = Wq + ((size_t)t.pn * BM * D + (size_t)h * HD) * 2; u.r0 = bh * NMEM; u.c0 = t.pn * BM; u.aux = 0; return true; }
};
struct MapVWT2 { const char* Vl; const char* Wo;
    __device__ __forceinline__ bool next(int i, GU& u) const { int c = (int)blockIdx.x; asm volatile("" : "+s"(c)); if (c < 128 || i >= 3) return false;
        const int idx = (c - 128) * 3 + i, bh = idx >> 3, pn = idx & 7, b = bh >> 2, h = bh & 3;
        u.A = Wo + ((size_t)pn * BM * D + (size_t)h * HD) * 2; u.B = Vl + ((size_t)b * NMEM * D + (size_t)h * HD) * 2; u.r0 = b * D + pn * BM; u.c0 = h * NMEM; u.aux = 1; return true; }
};
struct MapS2 {
    Order<M / BM, NH> o; const char* Xp; const char* MTp;
    __device__ __forceinline__ bool next(int i, GU& u) const { Tile t; if (!o.tile(i, t)) return false;
        u.A = Xp + (size_t)t.pm * BM * D * 2; u.B = MTp + (size_t)((t.pm >> 3) * NH + t.pn) * NMEM * D * 2; u.r0 = t.pm * BM; u.c0 = t.pn * NMEM; u.aux = t.pn; return true; }
};
struct MapPVO {
    Order<M / BM, D / BM> o; const char* P; const char* VW;
    __device__ __forceinline__ bool next(int i, GU& u) const { Tile t; if (!o.tile(i, t)) return false;
        u.A = P + (size_t)t.pm * BM * 1024 * 2; u.B = VW + ((size_t)(t.pm >> 3) * D + (size_t)t.pn * BM) * 1024 * 2; u.r0 = t.pm * BM; u.c0 = t.pn * BM; u.aux = t.pn; return true; }
};

__device__ __forceinline__ void rinv_dma(const float* rinv, const GU& u, int wr, int wc, int lane, LAS unsigned char* lds) {
    LAS unsigned char* dst = lds + RDMA_OFF + (wr * 4 + wc) * 512;
#pragma unroll
    for (int ai = 0; ai < 2; ++ai)
        __builtin_amdgcn_global_load_lds((const unsigned*)(rinv + u.r0 + ai * HALF + wr * 64 + lane), (LAS unsigned*)(dst + ai * 256), 4, 0, 0);
}
__device__ __forceinline__ float rinv_lds(LAS unsigned char* lds, int wr, int wc, int ai, int m, int fr) { return *(const LAS float*)(lds + RDMA_OFF + (wr * 4 + wc) * 512 + ai * 256 + (m * 16 + fr) * 4); }

template <bool SS, bool RS = false> struct EpiPlain {
    bf16_t* O; int ldc; float* ssp; const float* rinv;
    __device__ __forceinline__ void prefetch(const GU& u, int wr, int wc, int lane, LAS unsigned char* lds) const { if (RS) rinv_dma(rinv, u, wr, wc, lane, lds); }
    __device__ __forceinline__ void operator()(const f32x4 (&acc)[2][2][4][2], const GU& u, int wr, int wc, int fr, int fq, LAS unsigned char* lds) const {
        const int row0 = u.r0 + wr * 64 + fr, col0 = u.c0 + wc * 32 + 8 * fq;
#pragma unroll
        for (int ai = 0; ai < 2; ++ai)
#pragma unroll
            for (int m = 0; m < 4; ++m) { const int row = row0 + ai * HALF + m * 16; bf16_t* rowp = O + (size_t)row * ldc + col0; float s = 0.f;
                const float r = RS ? rinv_lds(lds, wr, wc, ai, m, fr) : 1.f;
#pragma unroll
                for (int bj = 0; bj < 2; ++bj) { f32x4 v0 = acc[ai][bj][m][0], v1 = acc[ai][bj][m][1];
                    if (RS) { v0 = v0 * r; v1 = v1 * r; }
                    if (SS) s += (v0[0] * v0[0] + v0[1] * v0[1]) + (v0[2] * v0[2] + v0[3] * v0[3]) + (v1[0] * v1[0] + v1[1] * v1[1]) + (v1[2] * v1[2] + v1[3] * v1[3]);
                    u32x4 w; w.x = cvt_pk_bf16(v0[0], v0[1]); w.y = cvt_pk_bf16(v0[2], v0[3]); w.z = cvt_pk_bf16(v1[0], v1[1]); w.w = cvt_pk_bf16(v1[2], v1[3]);
                    EPI_STORE((u32x4*)(rowp + bj * HALF), w); }
                if (SS) { s += __shfl_xor(s, 16); s += __shfl_xor(s, 32); if (fq == 0) ssp[(size_t)row * 32 + (u.c0 >> 8) * 4 + wc] = s; } }
    }
};
struct EpiGeluUV {
    bf16_t* U; bf16_t* V; float* vst; const float* rinv;
    __device__ __forceinline__ void prefetch(const GU& u, int wr, int wc, int lane, LAS unsigned char* lds) const { rinv_dma(rinv, u, wr, wc, lane, lds); }
    __device__ __forceinline__ void operator()(const f32x4 (&acc)[2][2][4][2], const GU& u, int wr, int wc, int fr, int fq, LAS unsigned char* lds) const {
        const bool isv = u.c0 >= DG; const int cbase = isv ? u.c0 - DG : u.c0; bf16_t* O = isv ? V : U;
        const int row0 = u.r0 + wr * 64 + fr, col0 = cbase + wc * 32 + 8 * fq;
#pragma unroll
        for (int ai = 0; ai < 2; ++ai)
#pragma unroll
            for (int m = 0; m < 4; ++m) { const int row = row0 + ai * HALF + m * 16; bf16_t* rowp = O + (size_t)row * DG + col0; float s = 0.f, q = 0.f;
                const float r = rinv_lds(lds, wr, wc, ai, m, fr);
#pragma unroll
                for (int bj = 0; bj < 2; ++bj) { f32x4 v0 = acc[ai][bj][m][0], v1 = acc[ai][bj][m][1];
#pragma unroll
                    for (int e = 0; e < 4; ++e) { v0[e] = gelu_tanh_f(v0[e] * r); v1[e] = gelu_tanh_f(v1[e] * r); }
                    s += (v0[0] + v0[1]) + (v0[2] + v0[3]) + (v1[0] + v1[1]) + (v1[2] + v1[3]);
                    q += (v0[0] * v0[0] + v0[1] * v0[1]) + (v0[2] * v0[2] + v0[3] * v0[3]) + (v1[0] * v1[0] + v1[1] * v1[1]) + (v1[2] * v1[2] + v1[3] * v1[3]);
                    u32x4 w; w.x = cvt_pk_bf16(v0[0], v0[1]); w.y = cvt_pk_bf16(v0[2], v0[3]); w.z = cvt_pk_bf16(v1[0], v1[1]); w.w = cvt_pk_bf16(v1[2], v1[3]);
                    EPI_STORE((u32x4*)(rowp + bj * HALF), w); }
                if (isv) { s += __shfl_xor(s, 16); s += __shfl_xor(s, 32); q += __shfl_xor(q, 16); q += __shfl_xor(q, 32);
                    if (fq == 0) *(f32x2*)(vst + ((size_t)row * 32 + (cbase >> 8) * 4 + wc) * 2) = (f32x2){s, q}; } }
    }
};
struct EpiSwiglu {
    bf16_t* HF; const float* rinv;
    __device__ __forceinline__ void prefetch(const GU& u, int wr, int wc, int lane, LAS unsigned char* lds) const { rinv_dma(rinv, u, wr, wc, lane, lds); }
    __device__ __forceinline__ void operator()(const f32x4 (&acc)[2][2][4][2], const GU& u, int wr, int wc, int fr, int fq, LAS unsigned char* lds) const {
        const int row0 = u.r0 + wr * 64 + fr, col0 = u.c0 + wc * 32 + 8 * fq;
#pragma unroll
        for (int ai = 0; ai < 2; ++ai)
#pragma unroll
            for (int m = 0; m < 4; ++m) { const int row = row0 + ai * HALF + m * 16; float o[8]; const float r = rinv_lds(lds, wr, wc, ai, m, fr);
#pragma unroll
                for (int n = 0; n < 2; ++n)
#pragma unroll
                    for (int e = 0; e < 4; ++e) o[n * 4 + e] = silu_f(acc[ai][0][m][n][e] * r) * (acc[ai][1][m][n][e] * r);
                u32x4 w; w.x = cvt_pk_bf16(o[0], o[1]); w.y = cvt_pk_bf16(o[2], o[3]); w.z = cvt_pk_bf16(o[4], o[5]); w.w = cvt_pk_bf16(o[6], o[7]);
                EPI_STORE((u32x4*)(HF + (size_t)row * DFF + col0), w); }
    }
};
struct EpiMTVWT {
    static constexpr int NS = 16, R2 = 0;
    bf16_t* MTp; bf16_t* VWp;
    __device__ __forceinline__ void prefetch(const GU&, int, int, int, LAS unsigned char*) const {}
    __device__ __forceinline__ void operator()(const f32x4 (&acc)[2][2][4][2], const GU& u, int wr, int wc, int fr, int fq, LAS unsigned char*) const {
        bf16_t* O = u.aux ? VWp : MTp; const int ldc = u.aux ? 1024 : D;
        const int row0 = u.r0 + wr * 64 + fr, col0 = u.c0 + wc * 32 + 8 * fq;
#pragma unroll
        for (int ai = 0; ai < 2; ++ai)
#pragma unroll
            for (int m = 0; m < 4; ++m) { bf16_t* rowp = O + (size_t)(row0 + ai * HALF + m * 16) * ldc + col0;
#pragma unroll
                for (int bj = 0; bj < 2; ++bj) { const f32x4 v0 = acc[ai][bj][m][0], v1 = acc[ai][bj][m][1];
                    u32x4 w; w.x = cvt_pk_bf16(v0[0], v0[1]); w.y = cvt_pk_bf16(v0[2], v0[3]); w.z = cvt_pk_bf16(v1[0], v1[1]); w.w = cvt_pk_bf16(v1[2], v1[3]);
                    *(u32x4*)(rowp + bj * HALF) = w; } }
    }
};
struct EpiSoftmax2 {
    static constexpr int NS = 16, R2 = 2;
    bf16_t* PT; const float* rinv;
    __device__ __forceinline__ void prefetch(const GU& u, int wr, int wc, int lane, LAS unsigned char* lds) const { rinv_dma(rinv, u, wr, wc, lane, lds); }
    __device__ __forceinline__ void operator()(f32x4 (&acc)[2][2][4][2], const GU& u, int wr, int wc, int fr, int fq, LAS unsigned char* lds) const {
        LAS float* red = (LAS float*)(lds + RED_OFF); LAS float* red2 = (LAS float*)(lds + RED2_OFF);
        constexpr float L2E = 1.4426950408889634f;
#pragma unroll
        for (int ai = 0; ai < 2; ++ai)
#pragma unroll
            for (int m = 0; m < 4; ++m) { const float r = rinv_lds(lds, wr, wc, ai, m, fr) * L2E; float mx = -3.0e38f;
#pragma unroll
                for (int bj = 0; bj < 2; ++bj)
#pragma unroll
                    for (int n = 0; n < 2; ++n) { acc[ai][bj][m][n] = acc[ai][bj][m][n] * r;
#pragma unroll
                        for (int e = 0; e < 4; ++e) mx = fmaxf(mx, acc[ai][bj][m][n][e]); }
                mx = fmaxf(mx, __shfl_xor(mx, 16)); mx = fmaxf(mx, __shfl_xor(mx, 32));
                if (fq == 0) red[(ai * HALF + wr * 64 + m * 16 + fr) * 4 + wc] = mx; }
        asm volatile("s_waitcnt lgkmcnt(0)" ::: "memory"); __builtin_amdgcn_s_barrier(); asm volatile("" ::: "memory");
#pragma unroll
        for (int ai = 0; ai < 2; ++ai)
#pragma unroll
            for (int m = 0; m < 4; ++m) { const int rl = ai * HALF + wr * 64 + m * 16 + fr;
                const f32x4 r4 = *(const LAS f32x4*)(red + rl * 4); const float mx = fmaxf(fmaxf(r4[0], r4[1]), fmaxf(r4[2], r4[3])); float sm = 0.f;
#pragma unroll
                for (int bj = 0; bj < 2; ++bj)
#pragma unroll
                    for (int n = 0; n < 2; ++n) {
#pragma unroll
                        for (int e = 0; e < 4; ++e) { const float p = __builtin_amdgcn_exp2f(acc[ai][bj][m][n][e] - mx); acc[ai][bj][m][n][e] = p; sm += p; } }
                sm += __shfl_xor(sm, 16); sm += __shfl_xor(sm, 32);
                if (fq == 0) red2[rl * 4 + wc] = sm; }
        asm volatile("s_waitcnt lgkmcnt(0)" ::: "memory"); __builtin_amdgcn_s_barrier(); asm volatile("" ::: "memory");
        const int row0 = u.r0 + wr * 64 + fr, col0 = u.c0 + wc * 32 + 8 * fq;
#pragma unroll
        for (int ai = 0; ai < 2; ++ai)
#pragma unroll
            for (int m = 0; m < 4; ++m) { const int rl = ai * HALF + wr * 64 + m * 16 + fr;
                const f32x4 s4 = *(const LAS f32x4*)(red2 + rl * 4); const float inv = 1.f / ((s4[0] + s4[1]) + (s4[2] + s4[3]));
                bf16_t* rowp = PT + (size_t)(row0 + ai * HALF + m * 16) * 1024 + col0;
#pragma unroll
                for (int bj = 0; bj < 2; ++bj) { const f32x4 v0 = acc[ai][bj][m][0] * inv, v1 = acc[ai][bj][m][1] * inv;
                    u32x4 w; w.x = cvt_pk_bf16(v0[0], v0[1]); w.y = cvt_pk_bf16(v0[2], v0[3]); w.z = cvt_pk_bf16(v1[0], v1[1]); w.w = cvt_pk_bf16(v1[2], v1[3]);
                    *(u32x4*)(rowp + bj * HALF) = w; } }
    }
};

struct Args { const float* in[21]; float* out; unsigned char* ws; };
struct Frame { LAS unsigned char* lds; int tid, lane, wave, vcu; static constexpr int G = GRID; };
__device__ __forceinline__ Frame make_frame(LAS unsigned char* lds) {
    Frame F; F.lds = lds; int t_ = threadIdx.x; asm volatile("" : "+v"(t_)); F.tid = t_; F.lane = F.tid & 63; F.wave = __builtin_amdgcn_readfirstlane(F.tid >> 6);
    int bx = blockIdx.x; asm volatile("" : "+s"(bx)); F.vcu = (bx % 8) * (GRID / 8) + bx / 8; return F; }

__device__ __forceinline__ void tr_item(const float* W, int ldw, int K, const float* kg, const float* ng, float cmul, bf16_t* WT, int blk, int blkstride, int blkoff,
                                        LAS float* scr, int item, int nblk, int lane) {
    const int kb = item / nblk, nb = item % nblk, k0 = 64 * kb, n0 = 64 * nb;
    const int n4 = (lane & 15) * 4, kr = lane >> 4;
    f32x4 gn = (f32x4){cmul, cmul, cmul, cmul}; if (ng) gn = *(const f32x4*)(ng + n0 + n4) * cmul;
    f32x4 v[16]; float gk[16];
#pragma unroll
    for (int i = 0; i < 16; ++i) v[i] = *(const f32x4*)(W + (size_t)(k0 + 4 * i + kr) * ldw + n0 + n4);
#pragma unroll
    for (int i = 0; i < 16; ++i) gk[i] = kg ? kg[k0 + 4 * i + kr] : 1.f;
#pragma unroll
    for (int i = 0; i < 16; ++i) { const f32x4 x = v[i] * gn * gk[i]; LAS float* d = scr + (4 * i + kr) * 65 + n4; d[0] = x[0]; d[1] = x[1]; d[2] = x[2]; d[3] = x[3]; }
    LDS_WAIT(); asm volatile("" ::: "memory");
    const int c = lane & 7;
    const int rbase = (n0 / blk) * blkstride + blkoff + (n0 % blk);
#pragma unroll
    for (int j = 0; j < 8; ++j) { const int n = (lane >> 3) + 8 * j; const LAS float* s = scr + (8 * c) * 65 + n;
        u32x4 o; o.x = cvt_pk_bf16(s[0 * 65], s[1 * 65]); o.y = cvt_pk_bf16(s[2 * 65], s[3 * 65]); o.z = cvt_pk_bf16(s[4 * 65], s[5 * 65]); o.w = cvt_pk_bf16(s[6 * 65], s[7 * 65]);
        *(u32x4*)(WT + (size_t)(rbase + n) * K + k0 + 8 * c) = o; }
    LDS_WAIT(); asm volatile("" ::: "memory");
}
__device__ __forceinline__ void conv_rows(const Frame& F, const float* W, bf16_t* O, int rows, int cols, const float* rg, float cmul) {
    const size_t n8 = (size_t)rows * cols / 8;
    for (size_t i = (size_t)F.vcu * NTHREADS + F.tid; i < n8; i += (size_t)GRID * NTHREADS) { const size_t e = i * 8; const float g = rg[e / cols] * cmul;
        const f32x4 a = *(const f32x4*)(W + e) * g, b = *(const f32x4*)(W + e + 4) * g;
        u32x4 w; w.x = cvt_pk_bf16(a[0], a[1]); w.y = cvt_pk_bf16(a[2], a[3]); w.z = cvt_pk_bf16(b[0], b[1]); w.w = cvt_pk_bf16(b[2], b[3]); *(u32x4*)(O + e) = w; }
}
__device__ __forceinline__ void tr_job(const Frame& F, int& base, const float* W, int ldw, int K, int N, const float* kg, const float* ng, float cmul, bf16_t* WT, int blk, int blkstride, int blkoff) {
    const int NGW = GRID * NWAVES, gw = F.vcu * NWAVES + F.wave;
    LAS float* scr = (LAS float*)(F.lds + F.wave * 16640);
    const int nblk = N / 64, nitems = (K / 64) * nblk;
    int first = (gw - (base % NGW) + NGW) % NGW;
    for (int it = first; it < nitems; it += NGW) tr_item(W, ldw, K, kg, ng, cmul, WT, blk, blkstride, blkoff, scr, it, nblk, F.lane);
    base += nitems;
}

template <bool NORM>
__device__ __forceinline__ void row_to_bf16(const float* src, bf16_t* dstb, float* rinv_out, int lane) {
    f32x4 v[8]; float ss = 0.f;
#pragma unroll
    for (int j = 0; j < 4; ++j) { const f32x4* p = (const f32x4*)(src + j * 512 + lane * 8); v[2 * j] = p[0]; v[2 * j + 1] = p[1]; }
#pragma unroll
    for (int j = 0; j < 8; ++j) ss += (v[j][0] * v[j][0] + v[j][1] * v[j][1]) + (v[j][2] * v[j][2] + v[j][3] * v[j][3]);
    const float rinv = rsqrtf(wave_sum(ss) * (1.f / D) + EPS); const float sc = NORM ? rinv : 1.f;
    if (!NORM && lane == 0) *rinv_out = rinv;
#pragma unroll
    for (int j = 0; j < 4; ++j) {
        const f32x4 a = v[2 * j] * sc, b = v[2 * j + 1] * sc;
        u32x4 w; w.x = cvt_pk_bf16(a[0], a[1]); w.y = cvt_pk_bf16(a[2], a[3]); w.z = cvt_pk_bf16(b[0], b[1]); w.w = cvt_pk_bf16(b[2], b[3]);
        *(u32x4*)(dstb + j * 512 + lane * 8) = w; }
}

template <bool FINAL>
__device__ __forceinline__ void row_pass(const Frame& F, bf16_t* XBp, const bf16_t* HB, const float* ssp, const float* g, float* rinv_out, float* OUT) {
    const int NGW = GRID * NWAVES, gw = F.vcu * NWAVES + F.wave, lane = F.lane;
    f32x4 gv[8];
#pragma unroll
    for (int j = 0; j < 4; ++j) { const f32x4* p = (const f32x4*)(g + j * 512 + lane * 8); gv[2 * j] = p[0]; gv[2 * j + 1] = p[1]; }
    for (int row = gw; row < M; row += NGW) {
        bf16_t* xr = XBp + (size_t)row * D; const bf16_t* hr = HB + (size_t)row * D;
        u32x4 xw[4], hw[4];
#pragma unroll
        for (int j = 0; j < 4; ++j) { xw[j] = *(const u32x4*)(xr + j * 512 + lane * 8); hw[j] = *(const u32x4*)(hr + j * 512 + lane * 8); }
        const float part = lane < 32 ? ssp[(size_t)row * 32 + lane] : 0.f;
        const float rh = rsqrtf(wave_sum(part) * (1.f / D) + EPS);
        float ss = 0.f;
#pragma unroll
        for (int j = 0; j < 4; ++j) {
            const f32x4 x0 = (f32x4){bf_lo(xw[j].x), bf_hi(xw[j].x), bf_lo(xw[j].y), bf_hi(xw[j].y)}, x1 = (f32x4){bf_lo(xw[j].z), bf_hi(xw[j].z), bf_lo(xw[j].w), bf_hi(xw[j].w)};
            const f32x4 h0 = (f32x4){bf_lo(hw[j].x), bf_hi(hw[j].x), bf_lo(hw[j].y), bf_hi(hw[j].y)}, h1 = (f32x4){bf_lo(hw[j].z), bf_hi(hw[j].z), bf_lo(hw[j].w), bf_hi(hw[j].w)};
            const f32x4 a = x0 + h0 * rh * gv[2 * j], b = x1 + h1 * rh * gv[2 * j + 1];
            if (FINAL) { f32x4* p = (f32x4*)(OUT + (size_t)row * D + j * 512 + lane * 8); p[0] = a; p[1] = b; }
            else { ss += (a[0] * a[0] + a[1] * a[1]) + (a[2] * a[2] + a[3] * a[3]) + (b[0] * b[0] + b[1] * b[1]) + (b[2] * b[2] + b[3] * b[3]);
                u32x4 w; w.x = cvt_pk_bf16(a[0], a[1]); w.y = cvt_pk_bf16(a[2], a[3]); w.z = cvt_pk_bf16(b[0], b[1]); w.w = cvt_pk_bf16(b[2], b[3]);
                *(u32x4*)(xr + j * 512 + lane * 8) = w; } }
        if (!FINAL) { const float rinv = rsqrtf(wave_sum(ss) * (1.f / D) + EPS); if (lane == 0) rinv_out[row] = rinv; }
    }
}

__device__ __forceinline__ void ld8(const bf16_t* p, float (&o)[8]) { const u32x4 w = *(const u32x4*)p; o[0] = bf_lo(w.x); o[1] = bf_hi(w.x); o[2] = bf_lo(w.y); o[3] = bf_hi(w.y); o[4] = bf_lo(w.z); o[5] = bf_hi(w.z); o[6] = bf_lo(w.w); o[7] = bf_hi(w.w); }
__device__ __forceinline__ void ld8s(const bf16_t* p, float sc, float (&o)[8]) { ld8(p, o);
#pragma unroll
    for (int e = 0; e < 8; ++e) o[e] *= sc; }
template <int H, int R> __device__ __forceinline__ void pool_item(const bf16_t* base, const float* rb0, int t0, bf16_t* dst) {
    constexpr int NR = R + 2 * H - 1;
    u32x4 rw[NR]; float wt[NR];
#pragma unroll
    for (int j = 0; j < NR; ++j) { const int tt = t0 - H + j, tc = tt < 0 ? 0 : (tt > SEQ - 1 ? SEQ - 1 : tt); rw[j] = *(const u32x4*)(base + (size_t)tc * D); wt[j] = (tt == tc) ? rb0[tc] : 0.f; }
    float s[8];
#pragma unroll
    for (int e = 0; e < 8; ++e) s[e] = 0.f;
#define POOL_ACC(j, sgn) do { const u32x4 q_ = rw[j]; const float w_ = (sgn) * wt[j]; \
        s[0] += bf_lo(q_.x) * w_; s[1] += bf_hi(q_.x) * w_; s[2] += bf_lo(q_.y) * w_; s[3] += bf_hi(q_.y) * w_; s[4] += bf_lo(q_.z) * w_; s[5] += bf_hi(q_.z) * w_; s[6] += bf_lo(q_.w) * w_; s[7] += bf_hi(q_.w) * w_; } while (0)
#pragma unroll
    for (int j = 0; j < 2 * H - 1; ++j) POOL_ACC(j, 1.f);
#pragma unroll
    for (int i = 0; i < R; ++i) { const int t = t0 + i;
        POOL_ACC(i + 2 * H - 1, 1.f);
        const int lo = t - H > 0 ? t - H : 0, hi = t + H < SEQ ? t + H : SEQ; const float ic = 1.f / (float)(hi - lo);
        const u32x4 q = rw[i + H]; const float wc = wt[i + H];
        float o[8]; o[0] = s[0] * ic - bf_lo(q.x) * wc; o[1] = s[1] * ic - bf_hi(q.x) * wc; o[2] = s[2] * ic - bf_lo(q.y) * wc; o[3] = s[3] * ic - bf_hi(q.y) * wc;
        o[4] = s[4] * ic - bf_lo(q.z) * wc; o[5] = s[5] * ic - bf_hi(q.z) * wc; o[6] = s[6] * ic - bf_lo(q.w) * wc; o[7] = s[7] * ic - bf_hi(q.w) * wc;
        u32x4 w; w.x = cvt_pk_bf16(o[0], o[1]); w.y = cvt_pk_bf16(o[2], o[3]); w.z = cvt_pk_bf16(o[4], o[5]); w.w = cvt_pk_bf16(o[6], o[7]);
        *(u32x4*)(dst + (size_t)i * D) = w;
        POOL_ACC(i, -1.f); }
#undef POOL_ACC
}
__device__ __forceinline__ void pool_pre(const Frame& F, const bf16_t* XBp, const float* rinv, bf16_t* DA) {
    const int gt = F.vcu * NTHREADS + F.tid, NT = GRID * NTHREADS;
    int kk = 0;
    for (int it = gt; it < (M / 16) * (D / 8); it += NT, ++kk) {
        const int cc = (it % (D / 8) + 64 * kk) % (D / 8), rb = it / (D / 8);
        const int grp = __builtin_amdgcn_readfirstlane(cc >> 6);
        const int r0 = __builtin_amdgcn_readfirstlane(rb * 16), t0 = r0 % SEQ; const bf16_t* base = XBp + (size_t)(r0 - t0) * D + cc * 8;
        const float* rb0 = rinv + (r0 - t0); bf16_t* dst = DA + (size_t)r0 * D + cc * 8;
        if (grp == 0) pool_item<1, 16>(base, rb0, t0, dst); else if (grp == 1) pool_item<2, 16>(base, rb0, t0, dst); else if (grp == 2) pool_item<4, 16>(base, rb0, t0, dst);
        else { pool_item<8, 8>(base, rb0, t0, dst); pool_item<8, 8>(base, rb0, t0 + 8, dst + (size_t)8 * D); }
    }
}

__device__ __forceinline__ int tswz(int c) { return ((c & 3) ^ ((((c >> 3) ^ (c >> 7)) & 1) | (((c >> 6) & 1) << 1))) | (((c >> 4) & 3) << 2); }
__device__ __forceinline__ void spatial_phase(const Frame& F, const bf16_t* U, const bf16_t* V, const float* vst, const bf16_t* Wsb, const float* bs, const float* lng, const float* lnb, bf16_t* GATED) {
    LAS unsigned char* T = F.lds; LAS f32x2* st = (LAS f32x2*)(F.lds + 65536);
    const int tid = F.tid, lane = F.lane, w = F.wave;
    for (int idx = F.vcu; idx < (M / 128) * 8; idx += GRID) {
        const int chunk = idx >> 3, head = idx & 7; const size_t rowb = (size_t)chunk * 128;
        __syncthreads();
        if (tid < 128) { const f32x4* p = (const f32x4*)(vst + (rowb + tid) * 64); float s = 0.f, q = 0.f;
#pragma unroll
            for (int i = 0; i < 16; ++i) { const f32x4 x = p[i]; s += x[0] + x[2]; q += x[1] + x[3]; }
            const float mu = s * (1.f / DG); const float var = q * (1.f / DG) - mu * mu; st[tid] = (f32x2){mu, rsqrtf(fmaxf(var, 0.f) + EPS)}; }
        __syncthreads();
        {
            const int c8 = (tid & 31) * 8, qg = tid >> 5; float lg[8], lb[8];
#pragma unroll
            for (int e = 0; e < 8; ++e) { lg[e] = lng[head * 256 + c8 + e]; lb[e] = lnb[head * 256 + c8 + e]; }
            float x[8][8];
#pragma unroll
            for (int r = 0; r < 8; ++r) { const int q = qg * 8 + r; float v[8]; ld8(V + (rowb + q) * DG + head * 256 + c8, v); const f32x2 ms = st[q];
#pragma unroll
                for (int e = 0; e < 8; ++e) x[r][e] = (v[e] - ms.x) * ms.y * lg[e] + lb[e]; }
#pragma unroll
            for (int e = 0; e < 8; ++e) { const int c = c8 + e; u32x4 wv; wv.x = cvt_pk_bf16(x[0][e], x[1][e]); wv.y = cvt_pk_bf16(x[2][e], x[3][e]); wv.z = cvt_pk_bf16(x[4][e], x[5][e]); wv.w = cvt_pk_bf16(x[6][e], x[7][e]);
                *(LAS u32x4*)(T + c * 256 + ((qg ^ tswz(c)) << 4)) = wv; }
        }
        bf16x8 wf[4];
#pragma unroll
        for (int ks = 0; ks < 4; ++ks) wf[ks] = *(const bf16x8*)(Wsb + ((size_t)head * 128 + 16 * w + (lane & 15)) * 128 + ks * 32 + (lane >> 4) * 8);
        __syncthreads();
        f32x4 acc[16];
#pragma unroll
        for (int nb = 0; nb < 16; ++nb) acc[nb] = (f32x4){0.f, 0.f, 0.f, 0.f};
        const int s = lane & 15, kq = lane >> 4;
#pragma unroll
        for (int nb = 0; nb < 16; ++nb) { const int c = 64 * (nb >> 2) + 16 * (s >> 2) + 4 * (nb & 3) + (s & 3); const int sw = tswz(c);
#pragma unroll
            for (int ks = 0; ks < 4; ++ks) { const bf16x8 tf = *(const LAS bf16x8*)(T + c * 256 + (((ks * 4 + kq) ^ sw) << 4));
                acc[nb] = __builtin_amdgcn_mfma_f32_16x16x32_bf16(tf, wf[ks], acc[nb], 0, 0, 0); } }
        const int p = 16 * w + (lane & 15), g4 = lane >> 4; const float bias = bs[head * 128 + p];
        const size_t orow = (rowb + p) * DG + head * 256;
#pragma unroll
        for (int a = 0; a < 4; ++a) { float ua[8], ub[8]; ld8(U + orow + 64 * a + 16 * g4, ua); ld8(U + orow + 64 * a + 16 * g4 + 8, ub);
            float o[16];
#pragma unroll
            for (int b = 0; b < 2; ++b)
#pragma unroll
                for (int e = 0; e < 4; ++e) { o[4 * b + e] = ua[4 * b + e] * (acc[4 * a + b][e] + bias); o[8 + 4 * b + e] = ub[4 * b + e] * (acc[4 * a + 2 + b][e] + bias); }
            u32x4 w0, w1; w0.x = cvt_pk_bf16(o[0], o[1]); w0.y = cvt_pk_bf16(o[2], o[3]); w0.z = cvt_pk_bf16(o[4], o[5]); w0.w = cvt_pk_bf16(o[6], o[7]);
            w1.x = cvt_pk_bf16(o[8], o[9]); w1.y = cvt_pk_bf16(o[10], o[11]); w1.z = cvt_pk_bf16(o[12], o[13]); w1.w = cvt_pk_bf16(o[14], o[15]);
            *(u32x4*)(GATED + orow + 64 * a + 16 * g4) = w0; *(u32x4*)(GATED + orow + 64 * a + 16 * g4 + 8) = w1; }
    }
    __syncthreads();
}

__device__ __forceinline__ const __attribute__((address_space(4))) Args* kargs() {
    const __attribute__((address_space(4))) Args* p = (const __attribute__((address_space(4))) Args*)__builtin_amdgcn_kernarg_segment_ptr();
    asm volatile("" : "+s"(p));
    return p;
}
#define KIN(k) (kargs()->in[k])
#define WSP(off) (kargs()->ws + (off))
#define x_prompt KIN(0)
#define x_sample KIN(1)
#define mem_prompt KIN(2)
#define mem_sample KIN(3)
#define norm_gains KIN(4)
#define mem_norm KIN(5)
#define pool_w KIN(6)
#define pool_scale KIN(7)
#define gmlp_w_in KIN(8)
#define gmlp_ln_g KIN(9)
#define gmlp_ln_b KIN(10)
#define gmlp_w_s KIN(11)
#define gmlp_b_s KIN(12)
#define gmlp_w_out KIN(13)
#define attn_wq KIN(14)
#define attn_wk KIN(15)
#define attn_wv KIN(16)
#define attn_wo KIN(17)
#define ffn_w_gate KIN(18)
#define ffn_w_up KIN(19)
#define ffn_w_down KIN(20)
#define X (kargs()->out)
#define WPOOL ((bf16_t*)WSP(WS_WPOOL))
#define WSB ((bf16_t*)WSP(WS_WS))
#define WIN ((bf16_t*)WSP(WS_WIN))
#define WOUT ((bf16_t*)WSP(WS_WOUT))
#define WQ ((bf16_t*)WSP(WS_WQ))
#define WK ((bf16_t*)WSP(WS_WK))
#define WV ((bf16_t*)WSP(WS_WV))
#define WO ((bf16_t*)WSP(WS_WO))
#define WGU ((bf16_t*)WSP(WS_WGU))
#define WDN ((bf16_t*)WSP(WS_WDN))
#define MEMBN ((bf16_t*)WSP(WS_MEMBN))
#define KMAT ((bf16_t*)WSP(WS_KMAT))
#define VT ((bf16_t*)WSP(WS_VT))
#define XB ((bf16_t*)WSP(WS_XB))
#define HB ((bf16_t*)WSP(WS_HB))
#define SSP ((float*)WSP(WS_SSP))
#define VST ((float*)WSP(WS_VST))
#define RSP ((float*)WSP(WS_RSP))
#define RINV ((float*)WSP(WS_RINV))
#define UB ((bf16_t*)WSP(WS_BIG + BIG_U))
#define VB ((bf16_t*)WSP(WS_BIG + BIG_V))
#define DA ((bf16_t*)WSP(WS_BIG + BIG_DA))
#define MTB ((bf16_t*)WSP(WS_BIG + BIG_MT))
#define VWTB ((bf16_t*)WSP(WS_BIG + BIG_VWT))
#define PT ((bf16_t*)WSP(WS_BIG + BIG_PT))
#define HF ((bf16_t*)WSP(WS_BIG + BIG_HF))
#define GATED UB

#define GRID_BAR() do { XcdBarrier _b; _b.bar = (unsigned*)WSP(WS_CTL) + CW_BAR; _b.x = xb_xcc_id(); _b.st = (volatile LAS unsigned*)(lds + MISC_OFF) + 8; xcd_barrier(_b); if (BARX2) xcd_barrier(_b); } while (0)
#define MK_STEP (size_t)BM * D * 2
__global__ void __launch_bounds__(NTHREADS, 2) mega_fwd(Args args) {
    extern __shared__ __attribute__((aligned(16))) unsigned char lds_raw[];
    LAS unsigned char* const lds = (LAS unsigned char*)lds_raw; (void)args;
    if (gridDim.x != GRID) return;
    { volatile LAS unsigned* MISC = (volatile LAS unsigned*)(lds + MISC_OFF); if (threadIdx.x < 32) MISC[threadIdx.x] = 0u; __syncthreads();
      (void)xcd_barrier_post((unsigned*)WSP(WS_CTL) + CW_BAR, MISC + 8); }

    {
        const Frame F = make_frame(lds); const int NGW = GRID * NWAVES, gw = F.vcu * NWAVES + F.wave;
        int base = 0;
        if (PH(0)) REP(0) for (int i = 0; i < DEPTH; ++i) {
            const float* g = norm_gains + (size_t)i * 6 * D;
            conv_rows(F, attn_wq + (size_t)i * D * D, WQ + (size_t)i * D * D, D, D, g + 2 * D, 0.04419417382415922f);
            tr_job(F, base, attn_wk + (size_t)i * D * D, D, D, D, mem_norm + (size_t)i * D, nullptr, 1.f, WK + (size_t)i * D * D, D, D, 0);
            tr_job(F, base, attn_wv + (size_t)i * D * D, D, D, D, mem_norm + (size_t)i * D, nullptr, 1.f, WV + (size_t)i * D * D, D, D, 0);
            tr_job(F, base, attn_wo + (size_t)i * D * D, D, D, D, nullptr, nullptr, 1.f, WO + (size_t)i * D * D, D, D, 0);
            tr_job(F, base, ffn_w_gate + (size_t)i * D * DFF, DFF, D, DFF, g + 4 * D, nullptr, 1.f, WGU + (size_t)i * 2 * DFF * D, 128, 256, 0);
            tr_job(F, base, ffn_w_up + (size_t)i * D * DFF, DFF, D, DFF, g + 4 * D, nullptr, 1.f, WGU + (size_t)i * 2 * DFF * D, 128, 256, 128);
            tr_job(F, base, ffn_w_down + (size_t)i * DFF * D, D, DFF, D, nullptr, nullptr, 1.f, WDN + (size_t)i * D * DFF, D, D, 0);
        }
        if (PH(0)) REP(0) for (int j = 0; j < 2; ++j) {
            const float* g0p = norm_gains + (size_t)(2 * j) * 6 * D;
            const float* g0g = norm_gains + (size_t)(2 * j + 1) * 6 * D;
            for (int gq = 0; gq < 4; ++gq)
                tr_job(F, base, pool_w + ((size_t)j * 4 + gq) * 512 * 512, 512, 512, 512, g0p + gq * 512, pool_scale + (size_t)j * D + gq * 512, 1.f, WPOOL + ((size_t)j * 4 + gq) * 512 * 512, 512, 512, 0);
            tr_job(F, base, gmlp_w_in + (size_t)j * D * 2 * DG, 2 * DG, D, 2 * DG, g0g, nullptr, 1.f, WIN + (size_t)j * 2 * DG * D, 2 * DG, 2 * DG, 0);
            tr_job(F, base, gmlp_w_out + (size_t)j * DG * D, D, DG, D, nullptr, nullptr, 1.f, WOUT + (size_t)j * D * DG, D, D, 0);
        }
        if (PH(1)) REP(1) for (int i = (F.vcu * NTHREADS + F.tid) * 8; i < 2 * 8 * 128 * 128; i += GRID * NTHREADS * 8) { const f32x4 a = *(const f32x4*)(gmlp_w_s + i), b = *(const f32x4*)(gmlp_w_s + i + 4);
            u32x4 w; w.x = cvt_pk_bf16(a[0], a[1]); w.y = cvt_pk_bf16(a[2], a[3]); w.z = cvt_pk_bf16(b[0], b[1]); w.w = cvt_pk_bf16(b[2], b[3]); *(u32x4*)(WSB + i) = w; }
        if (PH(1)) REP(1) for (int r = gw; r < MM; r += NGW) { const float* src = r < NPROMPT_MEM ? mem_prompt + (size_t)r * D : mem_sample + (size_t)(r - NPROMPT_MEM) * D; row_to_bf16<true>(src, MEMBN + (size_t)r * D, nullptr, F.lane); }
        if (PH(1)) REP(1) for (int r = gw; r < M; r += NGW) { const float* src = r < NPROMPT_ROWS ? x_prompt + (size_t)r * D : x_sample + (size_t)(r - NPROMPT_ROWS) * D; row_to_bf16<false>(src, XB + (size_t)r * D, RINV + r, F.lane); }
    }
    GRID_BAR();
    if (PH(2)) REP(2) {
        MapKV mp; mp.A = (const char*)MEMBN; mp.B = (const char*)WK;
        EpiPlain<false> E{KMAT, D, nullptr, nullptr};
        gemm_phase<EpiPlain<false>, MapKV, MK_ALIGN>(lds, mp, E, D, D, D);
    }
    GRID_BAR();

    for (int layer = 0; layer < DEPTH; ++layer) {
        if ((layer & 1) == 0) {
            if (PH(3)) REP(3) pool_pre(make_frame(lds), XB, RINV, DA);
            GRID_BAR();
            if (PH(4)) REP(4) {
#if PORDER
                MapPoolP mp;
#else
                MapPool mp;
#endif
                mp.A = (const char*)DA; mp.B = (const char*)(WPOOL + (size_t)(layer >> 1) * 4 * 512 * 512);
                EpiPlain<true> E{HB, D, SSP, nullptr};
                gemm_phase<EpiPlain<true>, decltype(mp), MK_ALIGN>(lds, mp, E, 512, D, 512); }
            GRID_BAR();
        } else {
            if (PH(5)) REP(5) {   MapReg<M / BM, (2 * DG) / BM, BM> mp; mp.A = (const char*)XB; mp.B = (const char*)(WIN + (size_t)(layer >> 1) * 2 * DG * D); mp.astep = MK_STEP; mp.bstep = MK_STEP;
                EpiGeluUV E{UB, VB, VST, RINV};
                gemm_phase<EpiGeluUV, MapReg<M / BM, (2 * DG) / BM, BM>, MK_ALIGN>(lds, mp, E, D, D, D); }
            GRID_BAR();
            if (PH(6)) REP(6) { const int j = layer >> 1; spatial_phase(make_frame(lds), UB, VB, VST, WSB + (size_t)j * 8 * 128 * 128, gmlp_b_s + (size_t)j * 8 * 128, gmlp_ln_g + (size_t)j * DG, gmlp_ln_b + (size_t)j * DG, GATED); }
            GRID_BAR();
            if (PH(7)) REP(7) {
#if PORDER
            MapRegP mp;
#else
            MapReg<M / BM, D / BM, BM> mp;
#endif
            mp.A = (const char*)GATED; mp.B = (const char*)(WOUT + (size_t)(layer >> 1) * D * DG); mp.astep = MK_STEP; mp.bstep = MK_STEP;
                EpiPlain<true> E{HB, D, SSP, nullptr};
                gemm_phase<EpiPlain<true>, decltype(mp), MK_ALIGN>(lds, mp, E, DG, DG, DG); }
            GRID_BAR();
        }
        if (PH(8)) row_pass<false>(make_frame(lds), XB, HB, SSP, norm_gains + ((size_t)layer * 6 + 1) * D, RINV, nullptr);
        if (PH(9)) REP(9) {   MapMT mp; mp.Kl = (const char*)(KMAT + (size_t)layer * MM * D); mp.Wq = (const char*)(WQ + (size_t)layer * D * D);
            EpiMTVWT E{MTB, VWTB};
            gemm_phase<EpiMTVWT, MapMT, MK_ALIGN>(lds, mp, E, HD, D, D); }
        GRID_BAR();
        if (PH(10)) REP(10) {   MapS2 mp; mp.Xp = (const char*)XB; mp.MTp = (const char*)MTB;
            EpiSoftmax2 E{PT, RINV};
            gemm_phase<EpiSoftmax2, MapS2, true>(lds, mp, E, D, D, D); }
        if (PH(9)) REP(9) {   MapVWT2 mp; mp.Vl = (const char*)(KMAT + (size_t)(4 + layer) * MM * D); mp.Wo = (const char*)(WO + (size_t)layer * D * D);
            EpiMTVWT E{MTB, VWTB};
            gemm_phase<EpiMTVWT, MapVWT2, MK_ALIGN>(lds, mp, E, HD, D, D); }
        GRID_BAR();
        if (PH(11)) REP(11) {   MapPVO mp; mp.P = (const char*)PT; mp.VW = (const char*)VWTB;
            EpiPlain<true> E{HB, D, SSP, nullptr};
            gemm_phase<EpiPlain<true>, MapPVO, MK_ALIGN>(lds, mp, E, 1024, 1024, 1024); }
        GRID_BAR();
        if (PH(8)) row_pass<false>(make_frame(lds), XB, HB, SSP, norm_gains + ((size_t)layer * 6 + 3) * D, RINV, nullptr);
        GRID_BAR();
        if (PH(13)) {   MapGUdyn mp; mp.A = (const char*)XB; mp.B = (const char*)(WGU + (size_t)layer * 2 * DFF * D); mp.ctr = (unsigned*)WSP(WS_CTL) + CW_GUQ + 64 * layer; mp.lds = lds;
            EpiSwiglu E{HF, RINV};
            gemm_phase<EpiSwiglu, MapGUdyn, false>(lds, mp, E, D, D, D); }
        GRID_BAR();
        if (PH(14)) REP(14) {
#if PORDER
            MapRegP mp;
#else
            MapReg<M / BM, D / BM, BM> mp;
#endif
            mp.A = (const char*)HF; mp.B = (const char*)(WDN + (size_t)layer * D * DFF); mp.astep = (size_t)BM * DFF * 2; mp.bstep = (size_t)BM * DFF * 2;
            EpiPlain<true> E{HB, D, SSP, nullptr};
            gemm_phase<EpiPlain<true>, decltype(mp), MK_ALIGN>(lds, mp, E, DFF, DFF, DFF); }
        GRID_BAR();
        if (layer < DEPTH - 1) { if (PH(8)) row_pass<false>(make_frame(lds), XB, HB, SSP, norm_gains + ((size_t)layer * 6 + 5) * D, RINV, nullptr); GRID_BAR(); }
        else if (PH(15)) row_pass<true>(make_frame(lds), XB, HB, SSP, norm_gains + ((size_t)layer * 6 + 5) * D, nullptr, X);
    }
}
}

static void mk_launch(void* const* d_in, void* d_out, void* d_ws, size_t ws_size, hipStream_t stream) {
    static int ok = 0;
    if (ok == 0) {
        ok = -1;
        if (ws_size < mk::WS_END) { fprintf(stderr, "kernel_launch: workspace too small (%zu < %zu)\n", ws_size, (size_t)mk::WS_END); return; }
        if (hipFuncSetAttribute((const void*)mk::mega_fwd, hipFuncAttributeMaxDynamicSharedMemorySize, mk::LDS_BYTES) != hipSuccess) { fprintf(stderr, "kernel_launch: hipFuncSetAttribute failed\n"); return; }
        int dev = 0, cus = 0, per_cu = 0;
        (void)hipGetDevice(&dev); (void)hipDeviceGetAttribute(&cus, hipDeviceAttributeMultiprocessorCount, dev);
        (void)hipOccupancyMaxActiveBlocksPerMultiprocessor(&per_cu, (const void*)mk::mega_fwd, mk::NTHREADS, mk::LDS_BYTES);
        (void)hipGetLastError();
        if (cus < mk::GRID || per_cu < 1) { fprintf(stderr, "kernel_launch: needs %d CUs with one resident block each (cus %d, per_cu %d)\n", mk::GRID, cus, per_cu); return; }
        ok = 1;
    }
    if (ok < 0) return;
    (void)hipMemsetAsync((char*)d_ws + mk::WS_CTL, 0, mk::CTL_BYTES, stream);
    mk::Args a{};
    for (int i = 0; i < 21; ++i) a.in[i] = (const float*)d_in[i];
    a.out = (float*)d_out; a.ws = (unsigned char*)d_ws;
    hipLaunchKernelGGL(mk::mega_fwd, dim3(mk::GRID), dim3(mk::NTHREADS), mk::LDS_BYTES, stream, a);
}

extern "C" void kernel_launch(void* const* d_in, const int* in_sizes, int n_in, void* d_out, int out_size, void* d_ws, size_t ws_size, hipStream_t stream) {
    (void)in_sizes; (void)n_in; (void)out_size;
    mk_launch(d_in, d_out, d_ws, ws_size, stream);
}
```

```cpp
#include <hip/hip_runtime.h>
#include <cstdio>
#include <cstdint>

namespace mk {
#define LAS __attribute__((address_space(3)))
#define GAS __attribute__((address_space(1)))
typedef unsigned short bf16_t;
typedef short bf16x8 __attribute__((ext_vector_type(8)));
typedef float f32x4 __attribute__((ext_vector_type(4)));
typedef float f32x2 __attribute__((ext_vector_type(2)));
typedef unsigned u32x4 __attribute__((ext_vector_type(4)));
typedef unsigned u32x2 __attribute__((ext_vector_type(2)));

constexpr int D = 2048, SEQ = 2048, NB = 12, M = NB * SEQ, DEPTH = 4, NMEM = 256, MM = NB * NMEM, DFF = 5632, NH = 4, HD = 512, DG = 2048;
constexpr int NPROMPT_ROWS = 4 * SEQ, NPROMPT_MEM = 4 * NMEM;
constexpr float EPS = 1e-6f;
constexpr int NWAVES = 8, NTHREADS = 512, GRID = 256;
#ifndef PHASES
#define PHASES 0xFFFFF
#endif
#define PH(b) ((PHASES >> (b)) & 1)
#ifndef MK_ALIGN
#define MK_ALIGN false
#endif
#ifndef EPI2
#define EPI2 0
#endif
#ifndef PORDER
#define PORDER 0
#endif
#ifndef STAG
#define STAG 0
#endif
#ifndef NSTAG
#define NSTAG 4
#endif
#ifndef EPI_NT
#define EPI_NT 0
#endif
#if EPI_NT
#define EPI_STORE(p, v) __builtin_nontemporal_store((v), (p))
#else
#define EPI_STORE(p, v) (*(p) = (v))
#endif
#ifndef MK_SP2
#define MK_SP2 1
#endif
#ifndef BARX2
#define BARX2 0
#endif
#ifndef ROWPROBE
#define ROWPROBE 0
#endif
#ifndef REPEAT
#define REPEAT 0
#endif
#define REP(b) for (int _r = 0; _r < 1 + ((REPEAT >> (b)) & 1); ++_r)

constexpr size_t MiB = 1u << 20;
constexpr size_t WS_CTL = 0, CTL_BYTES = 1 * MiB;
constexpr size_t WS_WPOOL = 1 * MiB;
constexpr size_t WS_WS = WS_WPOOL + 4 * MiB;
constexpr size_t WS_WIN = WS_WS + 1 * MiB;
constexpr size_t WS_WOUT = WS_WIN + 32 * MiB;
constexpr size_t WS_WQ = WS_WOUT + 16 * MiB;
constexpr size_t WS_WK = WS_WQ + 32 * MiB;
constexpr size_t WS_WV = WS_WK + 32 * MiB;
constexpr size_t WS_WO = WS_WV + 32 * MiB;
constexpr size_t WS_WGU = WS_WO + 32 * MiB;
constexpr size_t WS_WDN = WS_WGU + 176 * MiB;
constexpr size_t WS_MEMBN = WS_WDN + 88 * MiB;
constexpr size_t WS_KMAT = WS_MEMBN + 12 * MiB;
constexpr size_t WS_VT = WS_KMAT + 48 * MiB;
constexpr size_t WS_XB = WS_VT + 48 * MiB;
constexpr size_t WS_HB = WS_XB + 96 * MiB;
constexpr size_t WS_BIG = WS_HB + 96 * MiB;
constexpr size_t WS_SSP = WS_BIG + 264 * MiB;
constexpr size_t WS_VST = WS_SSP + 3 * MiB;
constexpr size_t WS_RSP = WS_VST + 6 * MiB;
constexpr size_t WS_RINV = WS_RSP + 2 * MiB;
constexpr size_t WS_END = WS_RINV + 1 * MiB;
constexpr size_t BIG_U = 0, BIG_V = 96 * MiB, BIG_DA = 0, BIG_MT = 0, BIG_VWT = 48 * MiB, BIG_PT = 192 * MiB, BIG_HF = 0;
constexpr int CW_BAR = 4096;
constexpr int CW_GUQ = 16384;

constexpr int RING_BYTES = 147456, RED_OFF = RING_BYTES, RED2_OFF = RED_OFF + 4096, RDMA_OFF = RED_OFF + 8192, MISC_OFF = RED_OFF + 12288, LDS_BYTES = 163840;

#define LDS_WAIT() asm volatile("s_waitcnt lgkmcnt(0)" ::: "memory")
#define VM_WAIT() asm volatile("s_waitcnt vmcnt(0)" ::: "memory")

#define XB_TMO      128
#define XB_XCNT(j)  (256  + 64 * (j))
#define XB_XSUB(j)  (1280 + 64 * (j))
#define XB_XGEN(j)  (2304 + 64 * (j))
#define XB_TOP      3328
#define XB_TOPGEN   3392
#define XCD_BAR_WORDS 3456
#define XB_SPIN_CAP (1u << 18)
__device__ __forceinline__ unsigned xb_ld(unsigned* p)              { return __hip_atomic_load(p, __ATOMIC_RELAXED, __HIP_MEMORY_SCOPE_AGENT); }
__device__ __forceinline__ unsigned xb_add(unsigned* p, unsigned v) { return __hip_atomic_fetch_add(p, v, __ATOMIC_RELAXED, __HIP_MEMORY_SCOPE_AGENT); }
__device__ __forceinline__ unsigned xb_xcc_id() { return (unsigned)__builtin_amdgcn_s_getreg((3 << 11) | 20) & 0xFu; }
#define XB_SPIN(cond, bar) do { unsigned _sp = 0; while (cond) { __builtin_amdgcn_s_sleep(1); \
    if ((++_sp & 255u) == 0u) { if (xb_ld(&(bar)[XB_TMO])) break; if (_sp > XB_SPIN_CAP) { atomicAdd(&(bar)[XB_TMO], 1u); break; } } } } while (0)
struct XcdBarrier { unsigned* bar; unsigned x; volatile LAS unsigned* st; };
__device__ __forceinline__ XcdBarrier xcd_barrier_post(unsigned* bar, volatile LAS unsigned* st) {
    XcdBarrier b; b.bar = bar; b.x = xb_xcc_id(); b.st = st;
    if (threadIdx.x == 0) (void)xb_add(&bar[XB_XCNT(b.x)], 1u);
    return b;
}
__device__ __forceinline__ void xcd_barrier_complete(unsigned* bar, unsigned x, unsigned& nloc, unsigned& nx) {
    const unsigned G = gridDim.x * gridDim.y * gridDim.z;
    unsigned sum, cnt, mine, sp = 0u;
    for (;;) {
        sum = 0u; cnt = 0u; mine = 0u;
#pragma unroll
        for (unsigned j = 0; j < 16; ++j) { const unsigned c = xb_ld(&bar[XB_XCNT(j)]); sum += c; cnt += (c > 0u) ? 1u : 0u; mine = (j == x) ? c : mine; }
        if (sum == G) break;
        __builtin_amdgcn_s_sleep(1);
        if ((++sp & 255u) == 0u) { if (xb_ld(&bar[XB_TMO])) break; if (sp > XB_SPIN_CAP) { atomicAdd(&bar[XB_TMO], 1u); break; } }
    }
    nloc = mine > 0u ? mine : 1u; nx = cnt > 0u ? cnt : 1u;
}
__device__ __forceinline__ void xcd_barrier(const XcdBarrier& b) {
    asm volatile("s_waitcnt vmcnt(0)" ::: "memory");
    __syncthreads();
    if (threadIdx.x == 0) {
        unsigned* bar = b.bar;
        __builtin_amdgcn_s_waitcnt(0);
        unsigned nloc = b.st[0], nx = b.st[1];
        if (nloc == 0u) { xcd_barrier_complete(bar, b.x, nloc, nx); b.st[0] = nloc; b.st[1] = nx; }
        const unsigned old = xb_add(&bar[XB_XSUB(b.x)], 1u);
        const unsigned gen = old / nloc;
        if (old + 1u == (gen + 1u) * nloc) {
            __builtin_amdgcn_fence(__ATOMIC_RELEASE, "agent");
            asm volatile("s_waitcnt vmcnt(0)" ::: "memory");
            const unsigned og = xb_add(&bar[XB_TOP], 1u);
            const unsigned tg = og / nx;
            if (og + 1u == (tg + 1u) * nx) xb_add(&bar[XB_TOPGEN], 1u);
            else XB_SPIN(xb_ld(&bar[XB_TOPGEN]) == tg, bar);
            __builtin_amdgcn_fence(__ATOMIC_ACQUIRE, "agent");
            xb_add(&bar[XB_XGEN(b.x)], 1u);
            asm volatile("s_waitcnt vmcnt(0)" ::: "memory");
        } else {
            XB_SPIN(xb_ld(&bar[XB_XGEN(b.x)]) == gen, bar);
            __builtin_amdgcn_fence(__ATOMIC_ACQUIRE, "agent");
            asm volatile("s_waitcnt vmcnt(0)" ::: "memory");
        }
    }
    __syncthreads();
}

__device__ __forceinline__ unsigned cvt_pk_bf16(float lo, float hi) { unsigned r; asm volatile("v_cvt_pk_bf16_f32 %0, %1, %2" : "=v"(r) : "v"(lo), "v"(hi)); return r; }
__device__ __forceinline__ float bf_lo(unsigned w) { return __uint_as_float(w << 16); }
__device__ __forceinline__ float bf_hi(unsigned w) { return __uint_as_float(w & 0xffff0000u); }
__device__ __forceinline__ float wave_sum(float v) {
#pragma unroll
    for (int o = 1; o < 64; o <<= 1) v += __shfl_xor(v, o);
    return v;
}
__device__ __forceinline__ float fast_exp(float x) { return __builtin_amdgcn_exp2f(x * 1.4426950408889634f); }
__device__ __forceinline__ float gelu_tanh_f(float x) {
    const float u = x * (1.5957691216057308f + 0.07135481282803448f * x * x);
    return x * __builtin_amdgcn_rcpf(1.f + fast_exp(-u));
}
__device__ __forceinline__ float silu_f(float x) { return x * __builtin_amdgcn_rcpf(1.f + fast_exp(-x)); }
__device__ __forceinline__ f32x4 zero_quad() { f32x2 a, b; asm volatile("v_mov_b64 %0, 0" : "=v"(a)); asm volatile("v_mov_b64 %0, 0" : "=v"(b)); return (f32x4){a[0], a[1], b[0], b[1]}; }
__device__ __forceinline__ f32x2 pr_lo(const f32x4& v) { return (f32x2){v[0], v[1]}; }
__device__ __forceinline__ f32x2 pr_hi(const f32x4& v) { return (f32x2){v[2], v[3]}; }
__device__ __forceinline__ f32x2 exp2_2(f32x2 t) { return (f32x2){__builtin_amdgcn_exp2f(t[0]), __builtin_amdgcn_exp2f(t[1])}; }
__device__ __forceinline__ f32x2 rcp_2(f32x2 t) { return (f32x2){__builtin_amdgcn_rcpf(t[0]), __builtin_amdgcn_rcpf(t[1])}; }

constexpr int BM = 256, BK = 64, HALF = 128, HTB = HALF * BK * 2, NXCD = 8, WGM = 4;
__device__ __forceinline__ int lds_byte(int r, int c) { const int st = (r >> 4) * 2 + (c >> 5), rr = r & 15, cc = c & 31, ob = rr * 64 + cc * 2; return st * 1024 + (ob ^ (((ob >> 9) & 1) << 5)); }
__device__ __forceinline__ void stage_rc(int b, int& R, int& C) { const int st = b / 1024, sb = b % 1024, swz = sb ^ (((sb >> 9) & 1) << 5); R = (st >> 1) * 16 + swz / 64; C = (st & 1) * 32 + (swz % 64) / 2; }
__device__ __forceinline__ int perm32(int rho) { const int n = rho >> 4, i = rho & 15; return 8 * (i >> 2) + 4 * n + (i & 3); }

struct GU { const char* A; const char* B; int r0, c0, aux; };
struct Tile { int pm, pn; };
template <int nM, int nN> struct Order {
    static constexpr int nwg = nM * nN, G = GRID;
    __device__ __forceinline__ bool tile(int i, Tile& t) const {
        int c = (int)blockIdx.x; asm volatile("" : "+s"(c));
        const long L = (long)i * G + c; if (L >= nwg) return false;
        int wgid = (int)L; { const int q = nwg / NXCD, r = nwg % NXCD, xcd = wgid % NXCD, off = wgid / NXCD; wgid = (xcd < r ? xcd * (q + 1) : r * (q + 1) + (xcd - r) * q) + off; }
        tile_wg(wgid, t); return true;
    }
    __device__ __forceinline__ void tile_wg(int wgid, Tile& t) const {
        const int nig = WGM * nN, gid = wgid / nig, fm = gid * WGM, gsz = (nM - fm) < WGM ? (nM - fm) : WGM;
        t.pm = fm + ((wgid % nig) % gsz); t.pn = (wgid % nig) / gsz;
    }
};
template <class Epi, class Map, bool ALIGN_EPI>
__device__ __forceinline__ void gemm_phase(LAS unsigned char* lds, const Map& S, const Epi& E, const int K, const int lda, const int ldb) {
    int tid_ = threadIdx.x; asm volatile("" : "+v"(tid_));
    const int tid = tid_, wid = __builtin_amdgcn_readfirstlane(tid >> 6), lane = tid & 63, wr = wid >> 2, wc = wid & 3, fr = lane & 15, fq = lane >> 4;
    const int nt = K / BK;
    unsigned voffA[2], voffB[2];
#pragma unroll
    for (int i = 0; i < 2; ++i) { int R, C; stage_rc(tid * 16 + i * 8192, R, C); const int Rb = (R & ~31) + perm32(R & 31);
        voffA[i] = (unsigned)(R * lda + C) * 2u; voffB[i] = (unsigned)(Rb * ldb + C) * 2u; }
    const size_t kstep = (size_t)(BK * 2);
    const size_t hstepA = (size_t)HALF * lda * 2, hstepB = (size_t)HALF * ldb * 2;
    const unsigned ldsw = (unsigned)wid * 1024u;
    const int aoff = lds_byte(wr * 64 + fr, fq * 8), boff = lds_byte(wc * 32 + fr, fq * 8);
#define PG8_SA(b, h) (((b) * 2 + (h)) * HTB)
#define PG8_SB(b, h) ((4 + (b) * 2 + (h)) * HTB)
#define PG8_STAGE(bufoff, gbase, voff) do { _Pragma("unroll") for (int _i = 0; _i < 2; ++_i) \
        __builtin_amdgcn_global_load_lds((const unsigned*)((const char*)(gbase) + (voff)[_i]), (LAS unsigned*)(lds + (bufoff) + ldsw + _i * 8192), 16, 0, 0); } while (0)
#define PG8_LDA(dst, b, h) do { _Pragma("unroll") for (int m = 0; m < 4; ++m) _Pragma("unroll") for (int k = 0; k < 2; ++k) dst[m][k] = *(const LAS bf16x8*)(lds + PG8_SA(b, h) + aoff + m * 2048 + k * 1024); } while (0)
#define PG8_LDA0(dst, roff) do { _Pragma("unroll") for (int m = 0; m < 4; ++m) _Pragma("unroll") for (int k = 0; k < 2; ++k) dst[m][k] = *(const LAS bf16x8*)(lds + (roff) + aoff + m * 2048 + k * 1024); } while (0)
#define PG8_LDB(dst, b, h) do { _Pragma("unroll") for (int n = 0; n < 2; ++n) _Pragma("unroll") for (int k = 0; k < 2; ++k) dst[n][k] = *(const LAS bf16x8*)(lds + PG8_SB(b, h) + boff + n * 2048 + k * 1024); } while (0)
#define PG8_MMA(ai, bj, At, Bt) do { __builtin_amdgcn_s_setprio(1); _Pragma("unroll") for (int m = 0; m < 4; ++m) _Pragma("unroll") for (int n = 0; n < 2; ++n) _Pragma("unroll") for (int k = 0; k < 2; ++k) \
        acc[ai][bj][m][n] = __builtin_amdgcn_mfma_f32_16x16x32_bf16(Bt[n][k], At[m][k], acc[ai][bj][m][n], 0, 0, 0); __builtin_amdgcn_s_setprio(0); } while (0)
#define PG8_WAIT_V(n) asm volatile("s_waitcnt vmcnt(" #n ")" ::: "memory")
#define PG8_WAIT_L(n) asm volatile("s_waitcnt lgkmcnt(" #n ")" ::: "memory")
#define PG8_BAR __builtin_amdgcn_s_barrier()
#define PG8_SCHED __builtin_amdgcn_sched_barrier(0)
    GU cur, nxt; int ui = 0;
    if (!S.next(0, cur)) return;
    if (STAG > 0) {
        int bx = (int)blockIdx.x; asm volatile("" : "+s"(bx)); const unsigned long long dl = (unsigned long long)(((bx >> 3) % NSTAG) * STAG);
        const unsigned long long t0 = __builtin_amdgcn_s_memrealtime(); while (__builtin_amdgcn_s_memrealtime() - t0 < dl) __builtin_amdgcn_s_sleep(2); }
    f32x4 acc[2][2][4][2];
#pragma unroll
    for (int a = 0; a < 2; ++a)
#pragma unroll
        for (int b = 0; b < 2; ++b)
#pragma unroll
            for (int m = 0; m < 4; ++m)
#pragma unroll
                for (int n = 0; n < 2; ++n) acc[a][b][m][n] = (f32x4){0.f, 0.f, 0.f, 0.f};
    bf16x8 At[4][2], B0[2][2], B1[2][2];
    const char* cA = cur.A; const char* cB = cur.B;
    E.prefetch(cur, wr, wc, lane, lds);
#if MK_SP2
    int ra0 = 0, ra1 = 2 * HTB, ra2 = 8 * HTB;
    PG8_STAGE(PG8_SB(0, 0), cB, voffB); PG8_STAGE(PG8_SB(0, 1), cB + hstepB, voffB); PG8_STAGE(ra0, cA, voffA); PG8_STAGE(PG8_SA(0, 1), cA + hstepA, voffA);
    if (wr == 1) PG8_BAR;
    PG8_WAIT_V(2); PG8_BAR;
#else
    PG8_STAGE(PG8_SB(0, 0), cB, voffB); PG8_STAGE(PG8_SA(0, 0), cA, voffA); PG8_STAGE(PG8_SB(0, 1), cB + hstepB, voffB); PG8_STAGE(PG8_SA(0, 1), cA + hstepA, voffA);
    if (wr == 1) PG8_BAR;
    PG8_WAIT_V(4); PG8_BAR;
#endif
    PG8_STAGE(PG8_SB(1, 0), cB + kstep, voffB); PG8_STAGE(ra1, cA + kstep, voffA); PG8_STAGE(PG8_SB(1, 1), cB + hstepB + kstep, voffB);
    PG8_WAIT_V(6); PG8_BAR;
    for (;;) {
        const bool has_next = S.next(ui + 1, nxt);
        const char* nA = has_next ? nxt.A : cA; const char* nB = has_next ? nxt.B : cB;
        for (int t = 0; t < nt; t += 2) {
            const bool last = (t == nt - 2);
            const char* a1 = cA + (size_t)(t + 1) * kstep;
            const char* a2 = last ? nA : cA + (size_t)(t + 2) * kstep; const char* b2 = last ? nB : cB + (size_t)(t + 2) * kstep;
            const char* a3 = a2 + kstep; const char* b3 = b2 + kstep;
#if MK_SP2
            PG8_LDB(B0, 0, 0); PG8_LDB(B1, 0, 1); PG8_SCHED; PG8_LDA0(At, ra0); PG8_STAGE(PG8_SA(1, 1), a1 + hstepA, voffA); PG8_STAGE(ra2, a2, voffA);
            PG8_WAIT_V(8); PG8_WAIT_L(0); PG8_BAR; PG8_MMA(0, 0, At, B0); PG8_MMA(0, 1, At, B1); PG8_BAR; PG8_SCHED;
            PG8_LDA(At, 0, 1); PG8_STAGE(PG8_SB(0, 0), b2, voffB); PG8_STAGE(PG8_SB(0, 1), b2 + hstepB, voffB);
            PG8_WAIT_V(8); PG8_WAIT_L(0); PG8_BAR; PG8_MMA(1, 0, At, B0); PG8_MMA(1, 1, At, B1); PG8_BAR; PG8_SCHED;
            PG8_LDB(B0, 1, 0); PG8_LDB(B1, 1, 1); PG8_SCHED; PG8_LDA0(At, ra1); PG8_STAGE(PG8_SA(0, 1), a2 + hstepA, voffA); PG8_STAGE(ra0, a3, voffA);
            PG8_WAIT_V(8); PG8_WAIT_L(0); PG8_BAR; PG8_MMA(0, 0, At, B0); PG8_MMA(0, 1, At, B1); PG8_BAR; PG8_SCHED;
            PG8_LDA(At, 1, 1); PG8_STAGE(PG8_SB(1, 0), b3, voffB); PG8_STAGE(PG8_SB(1, 1), b3 + hstepB, voffB);
            PG8_WAIT_V(8); PG8_WAIT_L(0); PG8_BAR; PG8_MMA(1, 0, At, B0); PG8_MMA(1, 1, At, B1); PG8_BAR; PG8_SCHED;
            { const int n0 = ra2, n1 = ra0, n2 = ra1; ra0 = n0; ra1 = n1; ra2 = n2; }
        #else
            PG8_LDB(B0, 0, 0); PG8_SCHED; PG8_LDA(At, 0, 0); PG8_STAGE(PG8_SA(1, 1), a1 + hstepA, voffA);
            PG8_WAIT_L(8); PG8_BAR; PG8_WAIT_L(0); PG8_MMA(0, 0, At, B0); PG8_BAR; PG8_SCHED;
            PG8_LDB(B1, 0, 1); PG8_STAGE(PG8_SB(0, 0), b2, voffB);
            PG8_BAR; PG8_WAIT_L(0); PG8_MMA(0, 1, At, B1); PG8_BAR;
            PG8_LDA(At, 0, 1); PG8_STAGE(PG8_SA(0, 0), a2, voffA);
            PG8_BAR; PG8_WAIT_L(0); PG8_MMA(1, 0, At, B0); PG8_BAR; PG8_SCHED;
            PG8_STAGE(PG8_SB(0, 1), b2 + hstepB, voffB);
            PG8_WAIT_V(6); PG8_BAR; PG8_MMA(1, 1, At, B1); PG8_BAR;
            PG8_LDB(B0, 1, 0); PG8_SCHED; PG8_LDA(At, 1, 0); PG8_STAGE(PG8_SA(0, 1), a2 + hstepA, voffA);
            PG8_WAIT_L(8); PG8_BAR; PG8_WAIT_L(0); PG8_MMA(0, 0, At, B0); PG8_BAR; PG8_SCHED;
            PG8_LDB(B1, 1, 1); PG8_STAGE(PG8_SB(1, 0), b3, voffB);
            PG8_BAR; PG8_WAIT_L(0); PG8_MMA(0, 1, At, B1); PG8_BAR;
            PG8_LDA(At, 1, 1); PG8_STAGE(PG8_SA(1, 0), a3, voffA);
            PG8_BAR; PG8_WAIT_L(0); PG8_MMA(1, 0, At, B0); PG8_BAR; PG8_SCHED;
            PG8_STAGE(PG8_SB(1, 1), b3 + hstepB, voffB);
            PG8_WAIT_V(6); PG8_BAR; PG8_MMA(1, 1, At, B1); PG8_BAR;
#endif
        }
        if constexpr (ALIGN_EPI) { if (wr == 0) PG8_BAR; }
        E(acc, cur, wr, wc, fr, fq, lds);
        if (EPI2) E(acc, cur, wr, wc, fr, fq, lds);
        if (!has_next) break;
#pragma unroll
        for (int a = 0; a < 2; ++a)
#pragma unroll
            for (int b = 0; b < 2; ++b)
#pragma unroll
                for (int m = 0; m < 4; ++m)
#pragma unroll
                    for (int n = 0; n < 2; ++n) acc[a][b][m][n] = zero_quad();
        cur = nxt; cA = nA; cB = nB; ++ui;
        E.prefetch(cur, wr, wc, lane, lds);
        if constexpr (ALIGN_EPI) { if (wr == 1) PG8_BAR; }
    }
    PG8_WAIT_V(0);
    if constexpr (!ALIGN_EPI) { if (wr == 0) PG8_BAR; }
    PG8_BAR;
#undef PG8_SA
#undef PG8_SB
#undef PG8_STAGE
#undef PG8_LDA
#undef PG8_LDA0
#undef PG8_LDB
#undef PG8_MMA
#undef PG8_WAIT_V
#undef PG8_WAIT_L
#undef PG8_BAR
#undef PG8_SCHED
}

template <int nM, int nN, int c0mul, int REVR = 0> struct MapReg {
    Order<nM, nN> o; const char* A; const char* B; size_t astep, bstep;
    __device__ __forceinline__ bool next(int i, GU& u) const { Tile t; if (REVR > 0) { if (i >= REVR) return false; i = REVR - 1 - i; } if (!o.tile(i, t)) return false;
        u.A = A + (size_t)t.pm * astep; u.B = B + (size_t)t.pn * bstep; u.r0 = t.pm * BM; u.c0 = t.pn * c0mul; u.aux = t.pn; return true; }
};
struct MapPool {
    Order<M / BM, D / BM> o; const char* A; const char* B;
    __device__ __forceinline__ bool next(int i, GU& u) const { Tile t; if (!o.tile(i, t)) return false;
        u.A = A + ((size_t)t.pm * BM * D + (size_t)(t.pn >> 1) * 512) * 2; u.B = B + (size_t)t.pn * BM * 512 * 2; u.r0 = t.pm * BM; u.c0 = t.pn * BM; u.aux = t.pn; return true; }
};
struct MapGUdyn { Order<M / BM, (2 * DFF) / BM> o; const char* A; const char* B; unsigned* ctr; LAS unsigned char* lds;
    __device__ __forceinline__ bool next(int i, GU& u) const { Tile t;
        if (i < 16) { if (!o.tile(i, t)) return false; }
        else {
            int tz = threadIdx.x; asm volatile("" : "+v"(tz)); const int wid = __builtin_amdgcn_readfirstlane(tz >> 6);
            volatile LAS unsigned* bw = (volatile LAS unsigned*)(lds + MISC_OFF) + 11;
            if (wid == 0) { unsigned tk = 0u; if ((tz & 63) == 0) tk = __hip_atomic_fetch_add(ctr, 1u, __ATOMIC_RELAXED, __HIP_MEMORY_SCOPE_AGENT);
                tk = (unsigned)__builtin_amdgcn_readfirstlane((int)tk); if ((tz & 63) == 0) *bw = tk; asm volatile("s_waitcnt lgkmcnt(0)" ::: "memory"); }
            asm volatile("" ::: "memory"); __builtin_amdgcn_s_barrier(); asm volatile("" ::: "memory");
            const unsigned tk = (unsigned)__builtin_amdgcn_readfirstlane((int)*bw);
            if (tk >= 128u) return false;
            o.tile_wg((int)(tk >> 4) * (o.nwg / NXCD) + (o.nwg / NXCD - 16) + (int)(tk & 15u), t);
        }
        u.A = A + (size_t)t.pm * BM * D * 2; u.B = B + (size_t)t.pn * BM * D * 2; u.r0 = t.pm * BM; u.c0 = t.pn * 128; u.aux = t.pn; return true; }
};
struct MapKV { Order<MM / BM, 64> o; const char* A; const char* B;
    __device__ __forceinline__ bool next(int i, GU& u) const { Tile t; if (!o.tile(i, t)) return false;
        u.A = A + (size_t)t.pm * BM * D * 2; u.B = B + (size_t)t.pn * BM * D * 2; u.r0 = (t.pn >> 3) * MM + t.pm * BM; u.c0 = (t.pn & 7) * BM; u.aux = 0; return true; }
};
struct MapMT { Order<48, 8> o; const char* Kl; const char* Wq;
    __device__ __forceinline__ bool next(int i, GU& u) const { Tile t; if (!o.tile(i, t)) return false;
        const int bh = t.pm, b = bh >> 2, h = bh & 3;
        u.A = Kl + ((size_t)b * NMEM * D + (size_t)h * HD) * 2; u.B = Wq + ((size_t)t.pn * BM * D + (size_t)h * HD) * 2; u.r0 = bh * NMEM; u.c0 = t.pn * BM; u.aux = 0; return true; }
};
struct MapVWT2 { const char* Vl; const char* Wo;
    __device__ __forceinline__ bool next(int i, GU& u) const { int c = (int)blockIdx.x; asm volatile("" : "+s"(c)); if (c < 128 || i >= 3) return false;
        const int idx = (c - 128) * 3 + i, bh = idx >> 3, pn = idx & 7, b = bh >> 2, h = bh & 3;
        u.A = Wo + ((size_t)pn * BM * D + (size_t)h * HD) * 2; u.B = Vl + ((size_t)b * NMEM * D + (size_t)h * HD) * 2; u.r0 = b * D + pn * BM; u.c0 = h * NMEM; u.aux = 1; return true; }
};
struct MapS2 {
    Order<M / BM, NH> o; const char* Xp; const char* MTp;
    __device__ __forceinline__ bool next(int i, GU& u) const { Tile t; if (!o.tile(i, t)) return false;
        u.A = Xp + (size_t)t.pm * BM * D * 2; u.B = MTp + (size_t)((t.pm >> 3) * NH + t.pn) * NMEM * D * 2; u.r0 = t.pm * BM; u.c0 = t.pn * NMEM; u.aux = t.pn; return true; }
};
struct MapPVO {
    Order<M / BM, D / BM> o; const char* P; const char* VW;
    __device__ __forceinline__ bool next(int i, GU& u) const { Tile t; if (!o.tile(i, t)) return false;
        u.A = P + (size_t)t.pm * BM * 1024 * 2; u.B = VW + ((size_t)(t.pm >> 3) * D + (size_t)t.pn * BM) * 1024 * 2; u.r0 = t.pm * BM; u.c0 = t.pn * BM; u.aux = t.pn; return true; }
};

__device__ __forceinline__ void rinv_dma(const float* rinv, const GU& u, int wr, int wc, int lane, LAS unsigned char* lds) {
    LAS unsigned char* dst = lds + RDMA_OFF + (wr * 4 + wc) * 512;
#pragma unroll
    for (int ai = 0; ai < 2; ++ai)
        __builtin_amdgcn_global_load_lds((const unsigned*)(rinv + u.r0 + ai * HALF + wr * 64 + lane), (LAS unsigned*)(dst + ai * 256), 4, 0, 0);
}
__device__ __forceinline__ float rinv_lds(LAS unsigned char* lds, int wr, int wc, int ai, int m, int fr) { return *(const LAS float*)(lds + RDMA_OFF + (wr * 4 + wc) * 512 + ai * 256 + (m * 16 + fr) * 4); }

template <bool SS, bool RS = false> struct EpiPlain {
    bf16_t* O; int ldc; float* ssp; const float* rinv;
    __device__ __forceinline__ void prefetch(const GU& u, int wr, int wc, int lane, LAS unsigned char* lds) const { if (RS) rinv_dma(rinv, u, wr, wc, lane, lds); }
    __device__ __forceinline__ void operator()(const f32x4 (&acc)[2][2][4][2], const GU& u, int wr, int wc, int fr, int fq, LAS unsigned char* lds) const {
        const int row0 = u.r0 + wr * 64 + fr, col0 = u.c0 + wc * 32 + 8 * fq;
#pragma unroll
        for (int ai = 0; ai < 2; ++ai)
#pragma unroll
            for (int m = 0; m < 4; ++m) { const int row = row0 + ai * HALF + m * 16; bf16_t* rowp = O + (size_t)row * ldc + col0; f32x2 s2 = (f32x2){0.f, 0.f};
                const float r = RS ? rinv_lds(lds, wr, wc, ai, m, fr) : 1.f;
#pragma unroll
                for (int bj = 0; bj < 2; ++bj) { f32x4 v0 = acc[ai][bj][m][0], v1 = acc[ai][bj][m][1];
                    if (RS) { v0 = v0 * r; v1 = v1 * r; }
                    if (SS) { const f32x2 a0 = pr_lo(v0), a1 = pr_hi(v0), a2 = pr_lo(v1), a3 = pr_hi(v1); s2 = a0 * a0 + s2; s2 = a1 * a1 + s2; s2 = a2 * a2 + s2; s2 = a3 * a3 + s2; }
                    u32x4 w; w.x = cvt_pk_bf16(v0[0], v0[1]); w.y = cvt_pk_bf16(v0[2], v0[3]); w.z = cvt_pk_bf16(v1[0], v1[1]); w.w = cvt_pk_bf16(v1[2], v1[3]);
                    EPI_STORE((u32x4*)(rowp + bj * HALF), w); }
                if (SS) { float s = s2[0] + s2[1]; s += __shfl_xor(s, 16); s += __shfl_xor(s, 32); if (fq == 0) ssp[(size_t)row * 32 + (u.c0 >> 8) * 4 + wc] = s; } }
    }
};
struct EpiGeluUV {
    static constexpr float GA = -1.5957691216057308f * 1.4426950408889634f, GB = -0.07135481282803448f * 1.4426950408889634f;
    bf16_t* U; bf16_t* V; float* vst; const float* rinv;
    __device__ __forceinline__ void prefetch(const GU& u, int wr, int wc, int lane, LAS unsigned char* lds) const { rinv_dma(rinv, u, wr, wc, lane, lds); }
    __device__ __forceinline__ void operator()(const f32x4 (&acc)[2][2][4][2], const GU& u, int wr, int wc, int fr, int fq, LAS unsigned char* lds) const {
        const bool isv = u.c0 >= DG; const int cbase = isv ? u.c0 - DG : u.c0; bf16_t* O = isv ? V : U;
        const int row0 = u.r0 + wr * 64 + fr, col0 = cbase + wc * 32 + 8 * fq;
#pragma unroll
        for (int ai = 0; ai < 2; ++ai)
#pragma unroll
            for (int m = 0; m < 4; ++m) { const int row = row0 + ai * HALF + m * 16; bf16_t* rowp = O + (size_t)row * DG + col0; f32x2 s2 = (f32x2){0.f, 0.f}, q2 = (f32x2){0.f, 0.f};
                const float r = rinv_lds(lds, wr, wc, ai, m, fr), ir = __builtin_amdgcn_rcpf(r), ga = GA * r, gb = GB * r * r * r;
#pragma unroll
                for (int bj = 0; bj < 2; ++bj) {
                    f32x2 x[4], t[4]; x[0] = pr_lo(acc[ai][bj][m][0]); x[1] = pr_hi(acc[ai][bj][m][0]); x[2] = pr_lo(acc[ai][bj][m][1]); x[3] = pr_hi(acc[ai][bj][m][1]);
#pragma unroll
                    for (int j = 0; j < 4; ++j) { t[j] = x[j] * x[j]; t[j] = t[j] * gb + ga; t[j] = t[j] * x[j]; }
#pragma unroll
                    for (int j = 0; j < 4; ++j) t[j] = exp2_2(t[j]);
#pragma unroll
                    for (int j = 0; j < 4; ++j) t[j] = t[j] * ir + ir;
#pragma unroll
                    for (int j = 0; j < 4; ++j) t[j] = rcp_2(t[j]);
#pragma unroll
                    for (int j = 0; j < 4; ++j) x[j] = x[j] * t[j];
                    if (isv) {
#pragma unroll
                        for (int j = 0; j < 4; ++j) { s2 = s2 + x[j]; q2 = x[j] * x[j] + q2; } }
                    u32x4 w; w.x = cvt_pk_bf16(x[0][0], x[0][1]); w.y = cvt_pk_bf16(x[1][0], x[1][1]); w.z = cvt_pk_bf16(x[2][0], x[2][1]); w.w = cvt_pk_bf16(x[3][0], x[3][1]);
                    EPI_STORE((u32x4*)(rowp + bj * HALF), w); }
                float s = s2[0] + s2[1], q = q2[0] + q2[1];
                if (isv) { s += __shfl_xor(s, 16); s += __shfl_xor(s, 32); q += __shfl_xor(q, 16); q += __shfl_xor(q, 32);
                    if (fq == 0) *(f32x2*)(vst + ((size_t)row * 32 + (cbase >> 8) * 4 + wc) * 2) = (f32x2){s, q}; } }
    }
};
struct EpiSwiglu {
    bf16_t* HF; const float* rinv;
    __device__ __forceinline__ void prefetch(const GU& u, int wr, int wc, int lane, LAS unsigned char* lds) const { rinv_dma(rinv, u, wr, wc, lane, lds); }
    __device__ __forceinline__ void operator()(const f32x4 (&acc)[2][2][4][2], const GU& u, int wr, int wc, int fr, int fq, LAS unsigned char* lds) const {
        const int row0 = u.r0 + wr * 64 + fr, col0 = u.c0 + wc * 32 + 8 * fq;
#pragma unroll
        for (int ai = 0; ai < 2; ++ai)
#pragma unroll
            for (int m = 0; m < 4; ++m) { const int row = row0 + ai * HALF + m * 16; const float r = rinv_lds(lds, wr, wc, ai, m, fr);
                const float rn = r * -1.4426950408889634f, ir2 = __builtin_amdgcn_rcpf(r * r); f32x2 g[4], p[4], t[4];
#pragma unroll
                for (int n = 0; n < 2; ++n) { g[2 * n] = pr_lo(acc[ai][0][m][n]); g[2 * n + 1] = pr_hi(acc[ai][0][m][n]); p[2 * n] = pr_lo(acc[ai][1][m][n]); p[2 * n + 1] = pr_hi(acc[ai][1][m][n]); }
#pragma unroll
                for (int j = 0; j < 4; ++j) t[j] = g[j] * rn;
#pragma unroll
                for (int j = 0; j < 4; ++j) t[j] = exp2_2(t[j]);
#pragma unroll
                for (int j = 0; j < 4; ++j) { t[j] = t[j] * ir2 + ir2; p[j] = g[j] * p[j]; }
#pragma unroll
                for (int j = 0; j < 4; ++j) t[j] = rcp_2(t[j]);
#pragma unroll
                for (int j = 0; j < 4; ++j) p[j] = p[j] * t[j];
                u32x4 w; w.x = cvt_pk_bf16(p[0][0], p[0][1]); w.y = cvt_pk_bf16(p[1][0], p[1][1]); w.z = cvt_pk_bf16(p[2][0], p[2][1]); w.w = cvt_pk_bf16(p[3][0], p[3][1]);
                EPI_STORE((u32x4*)(HF + (size_t)row * DFF + col0), w); }
    }
};
struct EpiMTVWT {
    static constexpr int NS = 16, R2 = 0;
    bf16_t* MTp; bf16_t* VWp;
    __device__ __forceinline__ void prefetch(const GU&, int, int, int, LAS unsigned char*) const {}
    __device__ __forceinline__ void operator()(const f32x4 (&acc)[2][2][4][2], const GU& u, int wr, int wc, int fr, int fq, LAS unsigned char*) const {
        bf16_t* O = u.aux ? VWp : MTp; const int ldc = u.aux ? 1024 : D;
        const int row0 = u.r0 + wr * 64 + fr, col0 = u.c0 + wc * 32 + 8 * fq;
#pragma unroll
        for (int ai = 0; ai < 2; ++ai)
#pragma unroll
            for (int m = 0; m < 4; ++m) { bf16_t* rowp = O + (size_t)(row0 + ai * HALF + m * 16) * ldc + col0;
#pragma unroll
                for (int bj = 0; bj < 2; ++bj) { const f32x4 v0 = acc[ai][bj][m][0], v1 = acc[ai][bj][m][1];
                    u32x4 w; w.x = cvt_pk_bf16(v0[0], v0[1]); w.y = cvt_pk_bf16(v0[2], v0[3]); w.z = cvt_pk_bf16(v1[0], v1[1]); w.w = cvt_pk_bf16(v1[2], v1[3]);
                    *(u32x4*)(rowp + bj * HALF) = w; } }
    }
};
struct EpiSoftmax2 {
    static constexpr int NS = 16, R2 = 2;
    bf16_t* PT; const float* rinv;
    __device__ __forceinline__ void prefetch(const GU& u, int wr, int wc, int lane, LAS unsigned char* lds) const { rinv_dma(rinv, u, wr, wc, lane, lds); }
    __device__ __forceinline__ void operator()(f32x4 (&acc)[2][2][4][2], const GU& u, int wr, int wc, int fr, int fq, LAS unsigned char* lds) const {
        LAS float* red = (LAS float*)(lds + RED_OFF); LAS float* red2 = (LAS float*)(lds + RED2_OFF);
        constexpr float L2E = 1.4426950408889634f;
#pragma unroll
        for (int ai = 0; ai < 2; ++ai)
#pragma unroll
            for (int m = 0; m < 4; ++m) { const float r = rinv_lds(lds, wr, wc, ai, m, fr) * L2E; float mx = -3.0e38f;
#pragma unroll
                for (int bj = 0; bj < 2; ++bj)
#pragma unroll
                    for (int n = 0; n < 2; ++n) { acc[ai][bj][m][n] = acc[ai][bj][m][n] * r;
#pragma unroll
                        for (int e = 0; e < 4; ++e) mx = fmaxf(mx, acc[ai][bj][m][n][e]); }
                mx = fmaxf(mx, __shfl_xor(mx, 16)); mx = fmaxf(mx, __shfl_xor(mx, 32));
                if (fq == 0) red[(ai * HALF + wr * 64 + m * 16 + fr) * 4 + wc] = mx; }
        asm volatile("s_waitcnt lgkmcnt(0)" ::: "memory"); __builtin_amdgcn_s_barrier(); asm volatile("" ::: "memory");
#pragma unroll
        for (int ai = 0; ai < 2; ++ai)
#pragma unroll
            for (int m = 0; m < 4; ++m) { const int rl = ai * HALF + wr * 64 + m * 16 + fr;
                const f32x4 r4 = *(const LAS f32x4*)(red + rl * 4); const float mx = fmaxf(fmaxf(r4[0], r4[1]), fmaxf(r4[2], r4[3])); float sm = 0.f;
#pragma unroll
                for (int bj = 0; bj < 2; ++bj)
#pragma unroll
                    for (int n = 0; n < 2; ++n) {
#pragma unroll
                        for (int e = 0; e < 4; ++e) { const float p = __builtin_amdgcn_exp2f(acc[ai][bj][m][n][e] - mx); acc[ai][bj][m][n][e] = p; sm += p; } }
                sm += __shfl_xor(sm, 16); sm += __shfl_xor(sm, 32);
                if (fq == 0) red2[rl * 4 + wc] = sm; }
        asm volatile("s_waitcnt lgkmcnt(0)" ::: "memory"); __builtin_amdgcn_s_barrier(); asm volatile("" ::: "memory");
        const int row0 = u.r0 + wr * 64 + fr, col0 = u.c0 + wc * 32 + 8 * fq;
#pragma unroll
        for (int ai = 0; ai < 2; ++ai)
#pragma unroll
            for (int m = 0; m < 4; ++m) { const int rl = ai * HALF + wr * 64 + m * 16 + fr;
                const f32x4 s4 = *(const LAS f32x4*)(red2 + rl * 4); const float inv = 1.f / ((s4[0] + s4[1]) + (s4[2] + s4[3]));
                bf16_t* rowp = PT + (size_t)(row0 + ai * HALF + m * 16) * 1024 + col0;
#pragma unroll
                for (int bj = 0; bj < 2; ++bj) { const f32x4 v0 = acc[ai][bj][m][0] * inv, v1 = acc[ai][bj][m][1] * inv;
                    u32x4 w; w.x = cvt_pk_bf16(v0[0], v0[1]); w.y = cvt_pk_bf16(v0[2], v0[3]); w.z = cvt_pk_bf16(v1[0], v1[1]); w.w = cvt_pk_bf16(v1[2], v1[3]);
                    *(u32x4*)(rowp + bj * HALF) = w; } }
    }
};

struct Args { const float* in[21]; float* out; unsigned char* ws; };
struct Frame { LAS unsigned char* lds; int tid, lane, wave, vcu; static constexpr int G = GRID; };
__device__ __forceinline__ Frame make_frame(LAS unsigned char* lds) {
    Frame F; F.lds = lds; int t_ = threadIdx.x; asm volatile("" : "+v"(t_)); F.tid = t_; F.lane = F.tid & 63; F.wave = __builtin_amdgcn_readfirstlane(F.tid >> 6);
    int bx = blockIdx.x; asm volatile("" : "+s"(bx)); F.vcu = (bx % 8) * (GRID / 8) + bx / 8; return F; }

__device__ __forceinline__ void tr_item(const float* W, int ldw, int K, const float* kg, const float* ng, float cmul, bf16_t* WT, int blk, int blkstride, int blkoff,
                                        LAS float* scr, int item, int nblk, int lane) {
    const int kb = item / nblk, nb = item % nblk, k0 = 64 * kb, n0 = 64 * nb;
    const int n4 = (lane & 15) * 4, kr = lane >> 4;
    f32x4 gn = (f32x4){cmul, cmul, cmul, cmul}; if (ng) gn = *(const f32x4*)(ng + n0 + n4) * cmul;
    f32x4 v[16]; float gk[16];
#pragma unroll
    for (int i = 0; i < 16; ++i) v[i] = *(const f32x4*)(W + (size_t)(k0 + 4 * i + kr) * ldw + n0 + n4);
#pragma unroll
    for (int i = 0; i < 16; ++i) gk[i] = kg ? kg[k0 + 4 * i + kr] : 1.f;
#pragma unroll
    for (int i = 0; i < 16; ++i) { const f32x4 x = v[i] * gn * gk[i]; LAS float* d = scr + (4 * i + kr) * 65 + n4; d[0] = x[0]; d[1] = x[1]; d[2] = x[2]; d[3] = x[3]; }
    LDS_WAIT(); asm volatile("" ::: "memory");
    const int c = lane & 7;
    const int rbase = (n0 / blk) * blkstride + blkoff + (n0 % blk);
#pragma unroll
    for (int j = 0; j < 8; ++j) { const int n = (lane >> 3) + 8 * j; const LAS float* s = scr + (8 * c) * 65 + n;
        u32x4 o; o.x = cvt_pk_bf16(s[0 * 65], s[1 * 65]); o.y = cvt_pk_bf16(s[2 * 65], s[3 * 65]); o.z = cvt_pk_bf16(s[4 * 65], s[5 * 65]); o.w = cvt_pk_bf16(s[6 * 65], s[7 * 65]);
        *(u32x4*)(WT + (size_t)(rbase + n) * K + k0 + 8 * c) = o; }
    LDS_WAIT(); asm volatile("" ::: "memory");
}
__device__ __forceinline__ void conv_rows(const Frame& F, const float* W, bf16_t* O, int rows, int cols, const float* rg, float cmul) {
    const size_t n8 = (size_t)rows * cols / 8;
    for (size_t i = (size_t)F.vcu * NTHREADS + F.tid; i < n8; i += (size_t)GRID * NTHREADS) { const size_t e = i * 8; const float g = rg[e / cols] * cmul;
        const f32x4 a = *(const f32x4*)(W + e) * g, b = *(const f32x4*)(W + e + 4) * g;
        u32x4 w; w.x = cvt_pk_bf16(a[0], a[1]); w.y = cvt_pk_bf16(a[2], a[3]); w.z = cvt_pk_bf16(b[0], b[1]); w.w = cvt_pk_bf16(b[2], b[3]); *(u32x4*)(O + e) = w; }
}
__device__ __forceinline__ void tr_job(const Frame& F, int& base, const float* W, int ldw, int K, int N, const float* kg, const float* ng, float cmul, bf16_t* WT, int blk, int blkstride, int blkoff) {
    const int NGW = GRID * NWAVES, gw = F.vcu * NWAVES + F.wave;
    LAS float* scr = (LAS float*)(F.lds + F.wave * 16640);
    const int nblk = N / 64, nitems = (K / 64) * nblk;
    int first = (gw - (base % NGW) + NGW) % NGW;
    for (int it = first; it < nitems; it += NGW) tr_item(W, ldw, K, kg, ng, cmul, WT, blk, blkstride, blkoff, scr, it, nblk, F.lane);
    base += nitems;
}

template <bool NORM>
__device__ __forceinline__ void row_to_bf16(const float* src, bf16_t* dstb, float* rinv_out, int lane) {
    f32x4 v[8]; float ss = 0.f;
#pragma unroll
    for (int j = 0; j < 4; ++j) { const f32x4* p = (const f32x4*)(src + j * 512 + lane * 8); v[2 * j] = p[0]; v[2 * j + 1] = p[1]; }
#pragma unroll
    for (int j = 0; j < 8; ++j) ss += (v[j][0] * v[j][0] + v[j][1] * v[j][1]) + (v[j][2] * v[j][2] + v[j][3] * v[j][3]);
    const float rinv = rsqrtf(wave_sum(ss) * (1.f / D) + EPS); const float sc = NORM ? rinv : 1.f;
    if (!NORM && lane == 0) *rinv_out = rinv;
#pragma unroll
    for (int j = 0; j < 4; ++j) {
        const f32x4 a = v[2 * j] * sc, b = v[2 * j + 1] * sc;
        u32x4 w; w.x = cvt_pk_bf16(a[0], a[1]); w.y = cvt_pk_bf16(a[2], a[3]); w.z = cvt_pk_bf16(b[0], b[1]); w.w = cvt_pk_bf16(b[2], b[3]);
        *(u32x4*)(dstb + j * 512 + lane * 8) = w; }
}

template <bool FINAL>
__device__ __forceinline__ void row_pass(const Frame& F, bf16_t* XBp, const bf16_t* HB, const float* ssp, const float* g, float* rinv_out, float* OUT) {
    const int NGW = GRID * NWAVES, gw = F.vcu * NWAVES + F.wave, lane = F.lane;
    f32x4 gv[8];
#pragma unroll
    for (int j = 0; j < 4; ++j) { const f32x4* p = (const f32x4*)(g + j * 512 + lane * 8); gv[2 * j] = p[0]; gv[2 * j + 1] = p[1]; }
    for (int row = gw; row < M; row += NGW) {
        bf16_t* xr = XBp + (size_t)row * D; const bf16_t* hr = HB + (size_t)row * D;
        u32x4 xw[4], hw[4];
#pragma unroll
        for (int j = 0; j < 4; ++j) { xw[j] = *(const u32x4*)(xr + j * 512 + lane * 8); hw[j] = *(const u32x4*)(hr + j * 512 + lane * 8); }
        const float part = lane < 32 ? ssp[(size_t)row * 32 + lane] : 0.f;
        const float rh = rsqrtf(wave_sum(part) * (1.f / D) + EPS);
        float ss = 0.f;
#pragma unroll
        for (int j = 0; j < 4; ++j) {
            const f32x4 x0 = (f32x4){bf_lo(xw[j].x), bf_hi(xw[j].x), bf_lo(xw[j].y), bf_hi(xw[j].y)}, x1 = (f32x4){bf_lo(xw[j].z), bf_hi(xw[j].z), bf_lo(xw[j].w), bf_hi(xw[j].w)};
            const f32x4 h0 = (f32x4){bf_lo(hw[j].x), bf_hi(hw[j].x), bf_lo(hw[j].y), bf_hi(hw[j].y)}, h1 = (f32x4){bf_lo(hw[j].z), bf_hi(hw[j].z), bf_lo(hw[j].w), bf_hi(hw[j].w)};
            const f32x4 a = x0 + h0 * rh * gv[2 * j], b = x1 + h1 * rh * gv[2 * j + 1];
            if (FINAL) { f32x4* p = (f32x4*)(OUT + (size_t)row * D + j * 512 + lane * 8); p[0] = a; p[1] = b; }
            else { ss += (a[0] * a[0] + a[1] * a[1]) + (a[2] * a[2] + a[3] * a[3]) + (b[0] * b[0] + b[1] * b[1]) + (b[2] * b[2] + b[3] * b[3]);
                u32x4 w; w.x = cvt_pk_bf16(a[0], a[1]); w.y = cvt_pk_bf16(a[2], a[3]); w.z = cvt_pk_bf16(b[0], b[1]); w.w = cvt_pk_bf16(b[2], b[3]);
                *(u32x4*)(xr + j * 512 + lane * 8) = w; } }
        if (!FINAL) { const float rinv = rsqrtf(wave_sum(ss) * (1.f / D) + EPS); if (lane == 0) rinv_out[row] = rinv; }
    }
}

__device__ __forceinline__ void ld8(const bf16_t* p, float (&o)[8]) { const u32x4 w = *(const u32x4*)p; o[0] = bf_lo(w.x); o[1] = bf_hi(w.x); o[2] = bf_lo(w.y); o[3] = bf_hi(w.y); o[4] = bf_lo(w.z); o[5] = bf_hi(w.z); o[6] = bf_lo(w.w); o[7] = bf_hi(w.w); }
__device__ __forceinline__ void ld8s(const bf16_t* p, float sc, float (&o)[8]) { ld8(p, o);
#pragma unroll
    for (int e = 0; e < 8; ++e) o[e] *= sc; }
template <int H, int R> __device__ __forceinline__ void pool_item(const bf16_t* base, const float* rb0, int t0, bf16_t* dst) {
    constexpr int NR = R + 2 * H - 1;
    u32x4 rw[NR]; float wt[NR];
#pragma unroll
    for (int j = 0; j < NR; ++j) { const int tt = t0 - H + j, tc = tt < 0 ? 0 : (tt > SEQ - 1 ? SEQ - 1 : tt); rw[j] = *(const u32x4*)(base + (size_t)tc * D); wt[j] = (tt == tc) ? rb0[tc] : 0.f; }
    float s[8];
#pragma unroll
    for (int e = 0; e < 8; ++e) s[e] = 0.f;
#define POOL_ACC(j, sgn) do { const u32x4 q_ = rw[j]; const float w_ = (sgn) * wt[j]; \
        s[0] += bf_lo(q_.x) * w_; s[1] += bf_hi(q_.x) * w_; s[2] += bf_lo(q_.y) * w_; s[3] += bf_hi(q_.y) * w_; s[4] += bf_lo(q_.z) * w_; s[5] += bf_hi(q_.z) * w_; s[6] += bf_lo(q_.w) * w_; s[7] += bf_hi(q_.w) * w_; } while (0)
#pragma unroll
    for (int j = 0; j < 2 * H - 1; ++j) POOL_ACC(j, 1.f);
#pragma unroll
    for (int i = 0; i < R; ++i) { const int t = t0 + i;
        POOL_ACC(i + 2 * H - 1, 1.f);
        const int lo = t - H > 0 ? t - H : 0, hi = t + H < SEQ ? t + H : SEQ; const float ic = 1.f / (float)(hi - lo);
        const u32x4 q = rw[i + H]; const float wc = wt[i + H];
        float o[8]; o[0] = s[0] * ic - bf_lo(q.x) * wc; o[1] = s[1] * ic - bf_hi(q.x) * wc; o[2] = s[2] * ic - bf_lo(q.y) * wc; o[3] = s[3] * ic - bf_hi(q.y) * wc;
        o[4] = s[4] * ic - bf_lo(q.z) * wc; o[5] = s[5] * ic - bf_hi(q.z) * wc; o[6] = s[6] * ic - bf_lo(q.w) * wc; o[7] = s[7] * ic - bf_hi(q.w) * wc;
        u32x4 w; w.x = cvt_pk_bf16(o[0], o[1]); w.y = cvt_pk_bf16(o[2], o[3]); w.z = cvt_pk_bf16(o[4], o[5]); w.w = cvt_pk_bf16(o[6], o[7]);
        *(u32x4*)(dst + (size_t)i * D) = w;
        POOL_ACC(i, -1.f); }
#undef POOL_ACC
}
__device__ __forceinline__ void pool_pre(const Frame& F, const bf16_t* XBp, const float* rinv, bf16_t* DA) {
    const int gt = F.vcu * NTHREADS + F.tid, NT = GRID * NTHREADS;
    int kk = 0;
    for (int it = gt; it < (M / 16) * (D / 8); it += NT, ++kk) {
        const int cc = (it % (D / 8) + 64 * kk) % (D / 8), rb = it / (D / 8);
        const int grp = __builtin_amdgcn_readfirstlane(cc >> 6);
        const int r0 = __builtin_amdgcn_readfirstlane(rb * 16), t0 = r0 % SEQ; const bf16_t* base = XBp + (size_t)(r0 - t0) * D + cc * 8;
        const float* rb0 = rinv + (r0 - t0); bf16_t* dst = DA + (size_t)r0 * D + cc * 8;
        if (grp == 0) pool_item<1, 16>(base, rb0, t0, dst); else if (grp == 1) pool_item<2, 16>(base, rb0, t0, dst); else if (grp == 2) pool_item<4, 16>(base, rb0, t0, dst);
        else { pool_item<8, 8>(base, rb0, t0, dst); pool_item<8, 8>(base, rb0, t0 + 8, dst + (size_t)8 * D); }
    }
}

__device__ __forceinline__ int tswz(int c) { return ((c & 3) ^ ((((c >> 3) ^ (c >> 7)) & 1) | (((c >> 6) & 1) << 1))) | (((c >> 4) & 3) << 2); }
__device__ __forceinline__ void spatial_phase(const Frame& F, const bf16_t* U, const bf16_t* V, const float* vst, const bf16_t* Wsb, const float* bs, const float* lng, const float* lnb, bf16_t* GATED) {
    LAS unsigned char* T = F.lds; LAS f32x2* st = (LAS f32x2*)(F.lds + 65536);
    const int tid = F.tid, lane = F.lane, w = F.wave;
    for (int idx = F.vcu; idx < (M / 128) * 8; idx += GRID) {
        const int chunk = idx >> 3, head = idx & 7; const size_t rowb = (size_t)chunk * 128;
        __syncthreads();
        if (tid < 128) { const f32x4* p = (const f32x4*)(vst + (rowb + tid) * 64); float s = 0.f, q = 0.f;
#pragma unroll
            for (int i = 0; i < 16; ++i) { const f32x4 x = p[i]; s += x[0] + x[2]; q += x[1] + x[3]; }
            const float mu = s * (1.f / DG); const float var = q * (1.f / DG) - mu * mu; st[tid] = (f32x2){mu, rsqrtf(fmaxf(var, 0.f) + EPS)}; }
        __syncthreads();
        {
            const int c8 = (tid & 31) * 8, qg = tid >> 5; float lg[8], lb[8];
#pragma unroll
            for (int e = 0; e < 8; ++e) { lg[e] = lng[head * 256 + c8 + e]; lb[e] = lnb[head * 256 + c8 + e]; }
            float x[8][8];
#pragma unroll
            for (int r = 0; r < 8; ++r) { const int q = qg * 8 + r; float v[8]; ld8(V + (rowb + q) * DG + head * 256 + c8, v); const f32x2 ms = st[q];
#pragma unroll
                for (int e = 0; e < 8; ++e) x[r][e] = (v[e] - ms.x) * ms.y * lg[e] + lb[e]; }
#pragma unroll
            for (int e = 0; e < 8; ++e) { const int c = c8 + e; u32x4 wv; wv.x = cvt_pk_bf16(x[0][e], x[1][e]); wv.y = cvt_pk_bf16(x[2][e], x[3][e]); wv.z = cvt_pk_bf16(x[4][e], x[5][e]); wv.w = cvt_pk_bf16(x[6][e], x[7][e]);
                *(LAS u32x4*)(T + c * 256 + ((qg ^ tswz(c)) << 4)) = wv; }
        }
        bf16x8 wf[4];
#pragma unroll
        for (int ks = 0; ks < 4; ++ks) wf[ks] = *(const bf16x8*)(Wsb + ((size_t)head * 128 + 16 * w + (lane & 15)) * 128 + ks * 32 + (lane >> 4) * 8);
        __syncthreads();
        f32x4 acc[16];
#pragma unroll
        for (int nb = 0; nb < 16; ++nb) acc[nb] = (f32x4){0.f, 0.f, 0.f, 0.f};
        const int s = lane & 15, kq = lane >> 4;
#pragma unroll
        for (int nb = 0; nb < 16; ++nb) { const int c = 64 * (nb >> 2) + 16 * (s >> 2) + 4 * (nb & 3) + (s & 3); const int sw = tswz(c);
#pragma unroll
            for (int ks = 0; ks < 4; ++ks) { const bf16x8 tf = *(const LAS bf16x8*)(T + c * 256 + (((ks * 4 + kq) ^ sw) << 4));
                acc[nb] = __builtin_amdgcn_mfma_f32_16x16x32_bf16(tf, wf[ks], acc[nb], 0, 0, 0); } }
        const int p = 16 * w + (lane & 15), g4 = lane >> 4; const float bias = bs[head * 128 + p];
        const size_t orow = (rowb + p) * DG + head * 256;
#pragma unroll
        for (int a = 0; a < 4; ++a) { float ua[8], ub[8]; ld8(U + orow + 64 * a + 16 * g4, ua); ld8(U + orow + 64 * a + 16 * g4 + 8, ub);
            float o[16];
#pragma unroll
            for (int b = 0; b < 2; ++b)
#pragma unroll
                for (int e = 0; e < 4; ++e) { o[4 * b + e] = ua[4 * b + e] * (acc[4 * a + b][e] + bias); o[8 + 4 * b + e] = ub[4 * b + e] * (acc[4 * a + 2 + b][e] + bias); }
            u32x4 w0, w1; w0.x = cvt_pk_bf16(o[0], o[1]); w0.y = cvt_pk_bf16(o[2], o[3]); w0.z = cvt_pk_bf16(o[4], o[5]); w0.w = cvt_pk_bf16(o[6], o[7]);
            w1.x = cvt_pk_bf16(o[8], o[9]); w1.y = cvt_pk_bf16(o[10], o[11]); w1.z = cvt_pk_bf16(o[12], o[13]); w1.w = cvt_pk_bf16(o[14], o[15]);
            *(u32x4*)(GATED + orow + 64 * a + 16 * g4) = w0; *(u32x4*)(GATED + orow + 64 * a + 16 * g4 + 8) = w1; }
    }
    __syncthreads();
}

__device__ __forceinline__ const __attribute__((address_space(4))) Args* kargs() {
    const __attribute__((address_space(4))) Args* p = (const __attribute__((address_space(4))) Args*)__builtin_amdgcn_kernarg_segment_ptr();
    asm volatile("" : "+s"(p));
    return p;
}
#define KIN(k) (kargs()->in[k])
#define WSP(off) (kargs()->ws + (off))
#define x_prompt KIN(0)
#define x_sample KIN(1)
#define mem_prompt KIN(2)
#define mem_sample KIN(3)
#define norm_gains KIN(4)
#define mem_norm KIN(5)
#define pool_w KIN(6)
#define pool_scale KIN(7)
#define gmlp_w_in KIN(8)
#define gmlp_ln_g KIN(9)
#define gmlp_ln_b KIN(10)
#define gmlp_w_s KIN(11)
#define gmlp_b_s KIN(12)
#define gmlp_w_out KIN(13)
#define attn_wq KIN(14)
#define attn_wk KIN(15)
#define attn_wv KIN(16)
#define attn_wo KIN(17)
#define ffn_w_gate KIN(18)
#define ffn_w_up KIN(19)
#define ffn_w_down KIN(20)
#define X (kargs()->out)
#define WPOOL ((bf16_t*)WSP(WS_WPOOL))
#define WSB ((bf16_t*)WSP(WS_WS))
#define WIN ((bf16_t*)WSP(WS_WIN))
#define WOUT ((bf16_t*)WSP(WS_WOUT))
#define WQ ((bf16_t*)WSP(WS_WQ))
#define WK ((bf16_t*)WSP(WS_WK))
#define WV ((bf16_t*)WSP(WS_WV))
#define WO ((bf16_t*)WSP(WS_WO))
#define WGU ((bf16_t*)WSP(WS_WGU))
#define WDN ((bf16_t*)WSP(WS_WDN))
#define MEMBN ((bf16_t*)WSP(WS_MEMBN))
#define KMAT ((bf16_t*)WSP(WS_KMAT))
#define VT ((bf16_t*)WSP(WS_VT))
#define XB ((bf16_t*)WSP(WS_XB))
#define HB ((bf16_t*)WSP(WS_HB))
#define SSP ((float*)WSP(WS_SSP))
#define VST ((float*)WSP(WS_VST))
#define RSP ((float*)WSP(WS_RSP))
#define RINV ((float*)WSP(WS_RINV))
#define UB ((bf16_t*)WSP(WS_BIG + BIG_U))
#define VB ((bf16_t*)WSP(WS_BIG + BIG_V))
#define DA ((bf16_t*)WSP(WS_BIG + BIG_DA))
#define MTB ((bf16_t*)WSP(WS_BIG + BIG_MT))
#define VWTB ((bf16_t*)WSP(WS_BIG + BIG_VWT))
#define PT ((bf16_t*)WSP(WS_BIG + BIG_PT))
#define HF ((bf16_t*)WSP(WS_BIG + BIG_HF))
#define GATED UB

#define GRID_BAR() do { XcdBarrier _b; _b.bar = (unsigned*)WSP(WS_CTL) + CW_BAR; _b.x = xb_xcc_id(); _b.st = (volatile LAS unsigned*)(lds + MISC_OFF) + 8; xcd_barrier(_b); if (BARX2) xcd_barrier(_b); } while (0)
#define MK_STEP (size_t)BM * D * 2
__global__ void __launch_bounds__(NTHREADS, 2) mega_fwd(Args args) {
    extern __shared__ __attribute__((aligned(16))) unsigned char lds_raw[];
    LAS unsigned char* const lds = (LAS unsigned char*)lds_raw; (void)args;
    if (gridDim.x != GRID) return;
    { volatile LAS unsigned* MISC = (volatile LAS unsigned*)(lds + MISC_OFF); if (threadIdx.x < 32) MISC[threadIdx.x] = 0u; __syncthreads();
      (void)xcd_barrier_post((unsigned*)WSP(WS_CTL) + CW_BAR, MISC + 8); }

    {
        const Frame F = make_frame(lds); const int NGW = GRID * NWAVES, gw = F.vcu * NWAVES + F.wave;
        int base = 0;
        if (PH(0)) REP(0) for (int i = 0; i < DEPTH; ++i) {
            const float* g = norm_gains + (size_t)i * 6 * D;
            conv_rows(F, attn_wq + (size_t)i * D * D, WQ + (size_t)i * D * D, D, D, g + 2 * D, 0.04419417382415922f);
            tr_job(F, base, attn_wk + (size_t)i * D * D, D, D, D, mem_norm + (size_t)i * D, nullptr, 1.f, WK + (size_t)i * D * D, D, D, 0);
            tr_job(F, base, attn_wv + (size_t)i * D * D, D, D, D, mem_norm + (size_t)i * D, nullptr, 1.f, WV + (size_t)i * D * D, D, D, 0);
            tr_job(F, base, attn_wo + (size_t)i * D * D, D, D, D, nullptr, nullptr, 1.f, WO + (size_t)i * D * D, D, D, 0);
            tr_job(F, base, ffn_w_gate + (size_t)i * D * DFF, DFF, D, DFF, g + 4 * D, nullptr, 1.f, WGU + (size_t)i * 2 * DFF * D, 128, 256, 0);
            tr_job(F, base, ffn_w_up + (size_t)i * D * DFF, DFF, D, DFF, g + 4 * D, nullptr, 1.f, WGU + (size_t)i * 2 * DFF * D, 128, 256, 128);
            tr_job(F, base, ffn_w_down + (size_t)i * DFF * D, D, DFF, D, nullptr, nullptr, 1.f, WDN + (size_t)i * D * DFF, D, D, 0);
        }
        if (PH(0)) REP(0) for (int j = 0; j < 2; ++j) {
            const float* g0p = norm_gains + (size_t)(2 * j) * 6 * D;
            const float* g0g = norm_gains + (size_t)(2 * j + 1) * 6 * D;
            for (int gq = 0; gq < 4; ++gq)
                tr_job(F, base, pool_w + ((size_t)j * 4 + gq) * 512 * 512, 512, 512, 512, g0p + gq * 512, pool_scale + (size_t)j * D + gq * 512, 1.f, WPOOL + ((size_t)j * 4 + gq) * 512 * 512, 512, 512, 0);
            tr_job(F, base, gmlp_w_in + (size_t)j * D * 2 * DG, 2 * DG, D, 2 * DG, g0g, nullptr, 1.f, WIN + (size_t)j * 2 * DG * D, 2 * DG, 2 * DG, 0);
            tr_job(F, base, gmlp_w_out + (size_t)j * DG * D, D, DG, D, nullptr, nullptr, 1.f, WOUT + (size_t)j * D * DG, D, D, 0);
        }
        if (PH(1)) REP(1) for (int i = (F.vcu * NTHREADS + F.tid) * 8; i < 2 * 8 * 128 * 128; i += GRID * NTHREADS * 8) { const f32x4 a = *(const f32x4*)(gmlp_w_s + i), b = *(const f32x4*)(gmlp_w_s + i + 4);
            u32x4 w; w.x = cvt_pk_bf16(a[0], a[1]); w.y = cvt_pk_bf16(a[2], a[3]); w.z = cvt_pk_bf16(b[0], b[1]); w.w = cvt_pk_bf16(b[2], b[3]); *(u32x4*)(WSB + i) = w; }
        if (PH(1)) REP(1) for (int r = gw; r < MM; r += NGW) { const float* src = r < NPROMPT_MEM ? mem_prompt + (size_t)r * D : mem_sample + (size_t)(r - NPROMPT_MEM) * D; row_to_bf16<true>(src, MEMBN + (size_t)r * D, nullptr, F.lane); }
        if (PH(1)) REP(1) for (int r = gw; r < M; r += NGW) { const float* src = r < NPROMPT_ROWS ? x_prompt + (size_t)r * D : x_sample + (size_t)(r - NPROMPT_ROWS) * D; row_to_bf16<false>(src, XB + (size_t)r * D, RINV + r, F.lane); }
    }
    GRID_BAR();
    if (PH(2)) REP(2) {
        MapKV mp; mp.A = (const char*)MEMBN; mp.B = (const char*)WK;
        EpiPlain<false> E{KMAT, D, nullptr, nullptr};
        gemm_phase<EpiPlain<false>, MapKV, MK_ALIGN>(lds, mp, E, D, D, D);
    }
    GRID_BAR();

    for (int layer = 0; layer < DEPTH; ++layer) {
        if ((layer & 1) == 0) {
            if (PH(3)) REP(3) pool_pre(make_frame(lds), XB, RINV, DA);
            GRID_BAR();
            if (PH(4)) REP(4) {
#if PORDER
                MapPoolP mp;
#else
                MapPool mp;
#endif
                mp.A = (const char*)DA; mp.B = (const char*)(WPOOL + (size_t)(layer >> 1) * 4 * 512 * 512);
                EpiPlain<true> E{HB, D, SSP, nullptr};
                gemm_phase<EpiPlain<true>, decltype(mp), MK_ALIGN>(lds, mp, E, 512, D, 512); }
            GRID_BAR();
        } else {
            if (PH(5)) REP(5) {   MapReg<M / BM, (2 * DG) / BM, BM> mp; mp.A = (const char*)XB; mp.B = (const char*)(WIN + (size_t)(layer >> 1) * 2 * DG * D); mp.astep = MK_STEP; mp.bstep = MK_STEP;
                EpiGeluUV E{UB, VB, VST, RINV};
                gemm_phase<EpiGeluUV, MapReg<M / BM, (2 * DG) / BM, BM>, MK_ALIGN>(lds, mp, E, D, D, D); }
            GRID_BAR();
            if (PH(6)) REP(6) { const int j = layer >> 1; spatial_phase(make_frame(lds), UB, VB, VST, WSB + (size_t)j * 8 * 128 * 128, gmlp_b_s + (size_t)j * 8 * 128, gmlp_ln_g + (size_t)j * DG, gmlp_ln_b + (size_t)j * DG, GATED); }
            GRID_BAR();
            if (PH(7)) REP(7) {
#if PORDER
            MapRegP mp;
#else
            MapReg<M / BM, D / BM, BM> mp;
#endif
            mp.A = (const char*)GATED; mp.B = (const char*)(WOUT + (size_t)(layer >> 1) * D * DG); mp.astep = MK_STEP; mp.bstep = MK_STEP;
                EpiPlain<true> E{HB, D, SSP, nullptr};
                gemm_phase<EpiPlain<true>, decltype(mp), MK_ALIGN>(lds, mp, E, DG, DG, DG); }
            GRID_BAR();
        }
        if (PH(8)) row_pass<false>(make_frame(lds), XB, HB, SSP, norm_gains + ((size_t)layer * 6 + 1) * D, RINV, nullptr);
        if (PH(9)) REP(9) {   MapMT mp; mp.Kl = (const char*)(KMAT + (size_t)layer * MM * D); mp.Wq = (const char*)(WQ + (size_t)layer * D * D);
            EpiMTVWT E{MTB, VWTB};
            gemm_phase<EpiMTVWT, MapMT, MK_ALIGN>(lds, mp, E, HD, D, D); }
        GRID_BAR();
        if (PH(10)) REP(10) {   MapS2 mp; mp.Xp = (const char*)XB; mp.MTp = (const char*)MTB;
            EpiSoftmax2 E{PT, RINV};
            gemm_phase<EpiSoftmax2, MapS2, true>(lds, mp, E, D, D, D); }
        if (PH(9)) REP(9) {   MapVWT2 mp; mp.Vl = (const char*)(KMAT + (size_t)(4 + layer) * MM * D); mp.Wo = (const char*)(WO + (size_t)layer * D * D);
            EpiMTVWT E{MTB, VWTB};
            gemm_phase<EpiMTVWT, MapVWT2, MK_ALIGN>(lds, mp, E, HD, D, D); }
        GRID_BAR();
        if (PH(11)) REP(11) {   MapPVO mp; mp.P = (const char*)PT; mp.VW = (const char*)VWTB;
            EpiPlain<true> E{HB, D, SSP, nullptr};
            gemm_phase<EpiPlain<true>, MapPVO, MK_ALIGN>(lds, mp, E, 1024, 1024, 1024); }
        GRID_BAR();
        if (PH(8)) row_pass<false>(make_frame(lds), XB, HB, SSP, norm_gains + ((size_t)layer * 6 + 3) * D, RINV, nullptr);
        GRID_BAR();
        if (PH(13)) {   MapGUdyn mp; mp.A = (const char*)XB; mp.B = (const char*)(WGU + (size_t)layer * 2 * DFF * D); mp.ctr = (unsigned*)WSP(WS_CTL) + CW_GUQ + 64 * layer; mp.lds = lds;
            EpiSwiglu E{HF, RINV};
            gemm_phase<EpiSwiglu, MapGUdyn, false>(lds, mp, E, D, D, D); }
        GRID_BAR();
        if (PH(14)) REP(14) {
#if PORDER
            MapRegP mp;
#else
            MapReg<M / BM, D / BM, BM, 3> mp;
#endif
            mp.A = (const char*)HF; mp.B = (const char*)(WDN + (size_t)layer * D * DFF); mp.astep = (size_t)BM * DFF * 2; mp.bstep = (size_t)BM * DFF * 2;
            EpiPlain<true> E{HB, D, SSP, nullptr};
            gemm_phase<EpiPlain<true>, decltype(mp), MK_ALIGN>(lds, mp, E, DFF, DFF, DFF); }
        GRID_BAR();
        if (layer < DEPTH - 1) { if (PH(8)) row_pass<false>(make_frame(lds), XB, HB, SSP, norm_gains + ((size_t)layer * 6 + 5) * D, RINV, nullptr); GRID_BAR(); }
        else if (PH(15)) row_pass<true>(make_frame(lds), XB, HB, SSP, norm_gains + ((size_t)layer * 6 + 5) * D, nullptr, X);
    }
}
}

static void mk_launch(void* const* d_in, void* d_out, void* d_ws, size_t ws_size, hipStream_t stream) {
    static int ok = 0;
    if (ok == 0) {
        ok = -1;
        if (ws_size < mk::WS_END) { fprintf(stderr, "kernel_launch: workspace too small (%zu < %zu)\n", ws_size, (size_t)mk::WS_END); return; }
        if (hipFuncSetAttribute((const void*)mk::mega_fwd, hipFuncAttributeMaxDynamicSharedMemorySize, mk::LDS_BYTES) != hipSuccess) { fprintf(stderr, "kernel_launch: hipFuncSetAttribute failed\n"); return; }
        int dev = 0, cus = 0, per_cu = 0;
        (void)hipGetDevice(&dev); (void)hipDeviceGetAttribute(&cus, hipDeviceAttributeMultiprocessorCount, dev);
        (void)hipOccupancyMaxActiveBlocksPerMultiprocessor(&per_cu, (const void*)mk::mega_fwd, mk::NTHREADS, mk::LDS_BYTES);
        (void)hipGetLastError();
        if (cus < mk::GRID || per_cu < 1) { fprintf(stderr, "kernel_launch: needs %d CUs with one resident block each (cus %d, per_cu %d)\n", mk::GRID, cus, per_cu); return; }
        ok = 1;
    }
    if (ok < 0) return;
    (void)hipMemsetAsync((char*)d_ws + mk::WS_CTL, 0, mk::CTL_BYTES, stream);
    mk::Args a{};
    for (int i = 0; i < 21; ++i) a.in[i] = (const float*)d_in[i];
    a.out = (float*)d_out; a.ws = (unsigned char*)d_ws;
    hipLaunchKernelGGL(mk::mega_fwd, dim3(mk::GRID), dim3(mk::NTHREADS), mk::LDS_BYTES, stream, a);
}

extern "C" void kernel_launch(void* const* d_in, const int* in_sizes, int n_in, void* d_out, int out_size, void* d_ws, size_t ws_size, hipStream_t stream) {
    (void)in_sizes; (void)n_in; (void)out_size;
    mk_launch(d_in, d_out, d_ws, ws_size, stream);
}
```
